# Optimizing an MI355X kernel written in HIP

```python
import math
import jax, jax.numpy as jnp
from jax import lax
import numpy as np

D_MODEL = 1024
BATCH = 4
SEQ = 4096
DEPTH = 2

N_MIXERS = 4
MIXER_WIDTH = D_MODEL // N_MIXERS
D_MIX = N_MIXERS * MIXER_WIDTH
GROUPS_PER_MIXER = 4
GROUP_DIM = MIXER_WIDTH // GROUPS_PER_MIXER
D_IN_PROJ = 8 * MIXER_WIDTH
SCONV_K = 3
SGU_CHUNK = 128
CCONV_K = 31
POOL_WINDOWS = (2, 4, 8, 16)
N_XATTN_HEADS = 4
XATTN_HEAD_DIM = D_MODEL // N_XATTN_HEADS
N_MEM = 256
D_FF = 2816
EPS = 1e-6

kernel_name = "hybrid_parallel_group_macaron_decoder"


def rmsnorm(x, g):
    xf = x.astype(jnp.float32)
    y = xf * lax.rsqrt(jnp.mean(xf * xf, axis=-1, keepdims=True) + EPS)
    return (y * g.astype(jnp.float32)).astype(x.dtype)


def layernorm(x, g, b=None):
    xf = x.astype(jnp.float32)
    mu = jnp.mean(xf, axis=-1, keepdims=True)
    var = jnp.mean(jnp.square(xf - mu), axis=-1, keepdims=True)
    y = (xf - mu) * lax.rsqrt(var + EPS) * g.astype(jnp.float32)
    if b is not None:
        y = y + b.astype(jnp.float32)
    return y.astype(x.dtype)


def swiglu_ffn(h, w_in, w_out):
    g, u = jnp.split(h @ w_in, 2, axis=-1)
    return (jax.nn.silu(g) * u) @ w_out


def causal_depthwise_conv(x, w):
    k = w.shape[0]
    return lax.conv_general_dilated(
        x, w[:, None, :].astype(x.dtype), window_strides=(1,), padding=((k - 1, 0),),
        dimension_numbers=("NWC", "WIO", "NWC"), feature_group_count=x.shape[-1])


def mixer_short_conv(bg, cg, xt, conv_w):
    return bg * causal_depthwise_conv(cg * xt, conv_w)


def mixer_spatial_gating(u, v, norm_g, w_s, b_s):
    bsz, s, _ = v.shape
    vn = layernorm(v, norm_g)
    vr = vn.reshape(bsz, s // SGU_CHUNK, SGU_CHUNK, GROUPS_PER_MIXER, GROUP_DIM)
    w_causal = jnp.tril(w_s)
    mixed = jnp.einsum("hts,bcshd->bcthd", w_causal.astype(vr.dtype), vr)
    mixed = mixed + b_s.T[None, None, :, :, None].astype(vr.dtype)
    return u * mixed.reshape(bsz, s, MIXER_WIDTH)


def mixer_conformer_conv(a, g, conv_w, ln_g, ln_b):
    y = a * jax.nn.sigmoid(g)
    y = causal_depthwise_conv(y, conv_w)
    y = layernorm(y, ln_g, ln_b)
    return jax.nn.silu(y)


def mixer_multiscale_pool(w, pool_w, pool_scale):
    bsz, s, _ = w.shape
    wf = w.astype(jnp.float32)
    cs = jnp.cumsum(wf, axis=1)
    pos = jnp.arange(s, dtype=jnp.int32)
    outs = []
    for gi, k in enumerate(POOL_WINDOWS):
        sl = slice(gi * GROUP_DIM, (gi + 1) * GROUP_DIM)
        csg = cs[:, :, sl]
        shifted = jnp.pad(csg, ((0, 0), (k, 0), (0, 0)))[:, :s]
        count = jnp.minimum(pos + 1, k).astype(jnp.float32)[None, :, None]
        outs.append((csg - shifted) / count - wf[:, :, sl])
    pooled = jnp.stack(outs, axis=2).astype(w.dtype)
    y = jnp.einsum("bsgc,gcd->bsgd", pooled, pool_w)
    return y.reshape(bsz, s, MIXER_WIDTH) * pool_scale


def cross_attention(h, m, wq, wkv, wo):
    bsz, s, _ = h.shape
    q = (h @ wq).reshape(bsz, s, N_XATTN_HEADS, XATTN_HEAD_DIM)
    k, v = jnp.split(m @ wkv, 2, axis=-1)
    k = k.reshape(bsz, N_MEM, N_XATTN_HEADS, XATTN_HEAD_DIM)
    v = v.reshape(bsz, N_MEM, N_XATTN_HEADS, XATTN_HEAD_DIM)
    scores = jnp.einsum("bshd,bmhd->bhsm", q, k).astype(jnp.float32) / math.sqrt(XATTN_HEAD_DIM)
    p = jax.nn.softmax(scores, axis=-1).astype(v.dtype)
    o = jnp.einsum("bhsm,bmhd->bshd", p, v).reshape(bsz, s, D_MODEL)
    return o @ wo


def setup_inputs(seed: int = 0) -> dict:
    key = jax.random.key(seed)
    ks = iter(jax.random.split(key, 32))
    L, D, W = DEPTH, D_MODEL, MIXER_WIDTH

    def nrm(shape, fan_in):
        return jax.random.normal(next(ks), shape, jnp.float32) * (fan_in ** -0.5)

    def gain(shape):
        return 1.0 + 0.02 * jax.random.normal(next(ks), shape, jnp.float32)

    def small(shape):
        return 0.02 * jax.random.normal(next(ks), shape, jnp.float32)

    return {
        "x": jax.random.normal(next(ks), (BATCH, SEQ, D), jnp.float32),
        "mem": jax.random.normal(next(ks), (BATCH, N_MEM, D), jnp.float32),
        "norm_ffn1": gain((L, D)),
        "ffn1_w_in": nrm((L, D, 2 * D_FF), D),
        "ffn1_w_out": nrm((L, D_FF, D), D_FF),
        "norm_mix": gain((L, D)),
        "mix_w_in": nrm((L, D, D_IN_PROJ), D),
        "sconv_w": nrm((L, SCONV_K, W), SCONV_K),
        "sgu_norm_g": gain((L, W)),
        "sgu_w": nrm((L, GROUPS_PER_MIXER, SGU_CHUNK, SGU_CHUNK), SGU_CHUNK),
        "sgu_b": gain((L, GROUPS_PER_MIXER, SGU_CHUNK)),
        "cconv_w": nrm((L, CCONV_K, W), CCONV_K),
        "cconv_ln_g": gain((L, W)),
        "cconv_ln_b": small((L, W)),
        "pool_w": nrm((L, len(POOL_WINDOWS), GROUP_DIM, GROUP_DIM), GROUP_DIM),
        "pool_scale": gain((L, W)),
        "mix_w_out": nrm((L, D_MIX, D), D_MIX),
        "norm_xattn": gain((L, D)),
        "norm_mem": gain((L, D)),
        "xattn_wq": nrm((L, D, D), D),
        "xattn_wkv": nrm((L, D, 2 * D), D),
        "xattn_wo": nrm((L, D, D), D),
        "norm_ffn2": gain((L, D)),
        "ffn2_w_in": nrm((L, D, 2 * D_FF), D),
        "ffn2_w_out": nrm((L, D_FF, D), D_FF),
        "norm_final": gain((D,)),
    }


def reference(x, mem, norm_ffn1, ffn1_w_in, ffn1_w_out, norm_mix, mix_w_in, sconv_w,
              sgu_norm_g, sgu_w, sgu_b, cconv_w, cconv_ln_g, cconv_ln_b, pool_w, pool_scale,
              mix_w_out, norm_xattn, norm_mem, xattn_wq, xattn_wkv, xattn_wo,
              norm_ffn2, ffn2_w_in, ffn2_w_out, norm_final):
    W = MIXER_WIDTH
    split_points = [W, 2 * W, 3 * W, 4 * W, 5 * W, 6 * W, 7 * W]
    for l in range(DEPTH):
        x = x + 0.5 * swiglu_ffn(rmsnorm(x, norm_ffn1[l]), ffn1_w_in[l], ffn1_w_out[l])

        h = rmsnorm(x, norm_mix[l])
        z = h @ mix_w_in[l]
        a_b, a_c, a_x, b_u, b_v, c_a, c_g, d_w = jnp.split(z, split_points, axis=-1)
        y_a = mixer_short_conv(a_b, a_c, a_x, sconv_w[l])
        y_b = mixer_spatial_gating(b_u, b_v, sgu_norm_g[l], sgu_w[l], sgu_b[l])
        y_c = mixer_conformer_conv(c_a, c_g, cconv_w[l], cconv_ln_g[l], cconv_ln_b[l])
        y_d = mixer_multiscale_pool(d_w, pool_w[l], pool_scale[l])
        y = jnp.concatenate([y_a, y_b, y_c, y_d], axis=-1)
        x = x + y @ mix_w_out[l]

        x = x + cross_attention(rmsnorm(x, norm_xattn[l]), rmsnorm(mem, norm_mem[l]),
                                xattn_wq[l], xattn_wkv[l], xattn_wo[l])

        x = x + 0.5 * swiglu_ffn(rmsnorm(x, norm_ffn2[l]), ffn2_w_in[l], ffn2_w_out[l])
    return rmsnorm(x, norm_final)
```

```cpp
#include <hip/hip_runtime.h>
#include <cstdio>
#include <cstdint>
namespace nv {
constexpr int D = 1024, SEQ = 4096, NB = 4, DFF = 2816, DZ = 2048, NMEM = 256;
constexpr float EPS = 1e-6f;

__device__ __forceinline__ float wsum(float v) {
#pragma unroll
    for (int o = 32; o > 0; o >>= 1) v += __shfl_xor(v, o);
    return v;
}
__device__ __forceinline__ float wmax(float v) {
#pragma unroll
    for (int o = 32; o > 0; o >>= 1) v = fmaxf(v, __shfl_xor(v, o));
    return v;
}

__global__ void k_rmsnorm(const float* x, const float* g, float* y, int rows) {
    const int row = blockIdx.x * 4 + threadIdx.x / 64, lane = threadIdx.x % 64;
    if (row >= rows) return;
    const float* xr = x + (size_t)row * D; float s = 0.f;
    for (int j = lane; j < D; j += 64) { const float v = xr[j]; s += v * v; }
    s = wsum(s); const float r = rsqrtf(s / D + EPS);
    for (int j = lane; j < D; j += 64) { const float v = xr[j]; y[(size_t)row * D + j] = v * r * g[j]; }
}

__global__ void k_ln256(const float* in, int ldi, const float* g, const float* b, float* out, int ldo, int rows, int do_silu) {
    const int row = blockIdx.x * 4 + threadIdx.x / 64, lane = threadIdx.x % 64;
    if (row >= rows) return;
    const float* p = in + (size_t)row * ldi;
    float v0 = p[lane], v1 = p[lane + 64], v2 = p[lane + 128], v3 = p[lane + 192];
    const float mu = wsum((v0 + v1) + (v2 + v3)) * (1.f / 256.f);
    v0 -= mu; v1 -= mu; v2 -= mu; v3 -= mu;
    const float var = wsum((v0 * v0 + v1 * v1) + (v2 * v2 + v3 * v3)) * (1.f / 256.f);
    const float r = rsqrtf(var + EPS);
    float* o = out + (size_t)row * ldo;
    float y0 = v0 * r * g[lane], y1 = v1 * r * g[lane + 64], y2 = v2 * r * g[lane + 128], y3 = v3 * r * g[lane + 192];
    if (b) { y0 += b[lane]; y1 += b[lane + 64]; y2 += b[lane + 128]; y3 += b[lane + 192]; }
    if (do_silu) { y0 = y0 / (1.f + expf(-y0)); y1 = y1 / (1.f + expf(-y1)); y2 = y2 / (1.f + expf(-y2)); y3 = y3 / (1.f + expf(-y3)); }
    o[lane] = y0; o[lane + 64] = y1; o[lane + 128] = y2; o[lane + 192] = y3;
}

__global__ void __launch_bounds__(256) k_gemm(const float* A, const float* W, float* C, int M, int N, int K, int lda, int ldw, int ldc) {
    __shared__ float As[16][68];
    __shared__ float Ws[16][64];
    const int t = threadIdx.x, tx = t % 16, ty = t / 16;
    const int m0 = blockIdx.y * 64, n0 = blockIdx.x * 64;
    float a00 = 0, a01 = 0, a02 = 0, a03 = 0, a10 = 0, a11 = 0, a12 = 0, a13 = 0, a20 = 0, a21 = 0, a22 = 0, a23 = 0, a30 = 0, a31 = 0, a32 = 0, a33 = 0;
    for (int k0 = 0; k0 < K; k0 += 16) {
        { const int r = t / 4, c = (t % 4) * 4; const float4 v = *(const float4*)(A + (size_t)(m0 + r) * lda + k0 + c);
          As[c + 0][r] = v.x; As[c + 1][r] = v.y; As[c + 2][r] = v.z; As[c + 3][r] = v.w; }
        { const int r = t / 16, c = (t % 16) * 4; const float4 v = *(const float4*)(W + (size_t)(k0 + r) * ldw + n0 + c);
          *(float4*)&Ws[r][c] = v; }
        __syncthreads();
#pragma unroll
        for (int k = 0; k < 16; ++k) {
            const float4 av = *(const float4*)&As[k][ty * 4];
            const float4 wv = *(const float4*)&Ws[k][tx * 4];
            a00 += av.x * wv.x; a01 += av.x * wv.y; a02 += av.x * wv.z; a03 += av.x * wv.w;
            a10 += av.y * wv.x; a11 += av.y * wv.y; a12 += av.y * wv.z; a13 += av.y * wv.w;
            a20 += av.z * wv.x; a21 += av.z * wv.y; a22 += av.z * wv.z; a23 += av.z * wv.w;
            a30 += av.w * wv.x; a31 += av.w * wv.y; a32 += av.w * wv.z; a33 += av.w * wv.w;
        }
        __syncthreads();
    }
    float* c = C + (size_t)(m0 + ty * 4) * ldc + n0 + tx * 4;
    *(float4*)(c) = make_float4(a00, a01, a02, a03);
    *(float4*)(c + ldc) = make_float4(a10, a11, a12, a13);
    *(float4*)(c + 2 * (size_t)ldc) = make_float4(a20, a21, a22, a23);
    *(float4*)(c + 3 * (size_t)ldc) = make_float4(a30, a31, a32, a33);
}

__global__ void k_swiglu(const float* G, float* act, int rows) {
    const size_t i = (size_t)blockIdx.x * 256 + threadIdx.x; if (i >= (size_t)rows * DFF) return;
    const size_t m = i / DFF; const int j = (int)(i % DFF);
    const float g = G[m * (2 * DFF) + j], u = G[m * (2 * DFF) + DFF + j];
    act[i] = g / (1.f + expf(-g)) * u;
}
__global__ void k_axpy(float* x, const float* c, float alpha, size_t n) {
    const size_t i = (size_t)blockIdx.x * 256 + threadIdx.x; if (i >= n) return;
    x[i] += alpha * c[i];
}
__global__ void k_copy(float* dst, const float* src, size_t n) {
    const size_t i = (size_t)blockIdx.x * 256 + threadIdx.x; if (i >= n) return;
    dst[i] = src[i];
}
__global__ void k_mix_a(const float* Z, const float* w, float* Y, int rows) {
    const int i = blockIdx.x * 256 + threadIdx.x; if (i >= rows * 256) return;
    const int t = i / 256, c = i % 256; float acc = 0.f;
    for (int k = 0; k < 3; ++k) { const int tt = t - 2 + k; if (tt >= 0) acc += w[k * 256 + c] * (Z[(size_t)tt * DZ + 256 + c] * Z[(size_t)tt * DZ + 512 + c]); }
    Y[(size_t)t * D + c] = Z[(size_t)t * DZ + c] * acc;
}
__global__ void k_mix_b(const float* Z, const float* vn, const float* ws, const float* bs, float* Y, int rows) {
    const int i = blockIdx.x * 256 + threadIdx.x; if (i >= rows * 256) return;
    const int t = i / 256, c = i % 256, ch = t / 128, tl = t % 128, h = c / 64; float acc = 0.f;
    const float* wr = ws + ((size_t)h * 128 + tl) * 128;
    for (int s = 0; s <= tl; ++s) acc += wr[s] * vn[(size_t)(ch * 128 + s) * 256 + c];
    acc += bs[h * 128 + tl];
    Y[(size_t)t * D + 256 + c] = Z[(size_t)t * DZ + 768 + c] * acc;
}
__global__ void k_glu(const float* Z, float* glu, int rows) {
    const int i = blockIdx.x * 256 + threadIdx.x; if (i >= rows * 256) return;
    const int t = i / 256, c = i % 256; const float a = Z[(size_t)t * DZ + 1280 + c], g = Z[(size_t)t * DZ + 1536 + c];
    glu[i] = a / (1.f + expf(-g));
}
__global__ void k_conv31(const float* glu, const float* w, float* out, int rows) {
    const int i = blockIdx.x * 256 + threadIdx.x; if (i >= rows * 256) return;
    const int t = i / 256, c = i % 256; float acc = 0.f;
    for (int k = 0; k < 31; ++k) { const int tt = t - 30 + k; if (tt >= 0) acc += w[k * 256 + c] * glu[(size_t)tt * 256 + c]; }
    out[i] = acc;
}
__global__ void k_pool(const float* Z, float* pooled, int rows) {
    const int i = blockIdx.x * 256 + threadIdx.x; if (i >= rows * 256) return;
    const int t = i / 256, c = i % 256, g = c / 64, k = 2 << g; float s = 0.f;
    for (int j = 0; j < k; ++j) if (t - j >= 0) s += Z[(size_t)(t - j) * DZ + 1792 + c];
    const int cnt = (t + 1 < k) ? t + 1 : k;
    pooled[i] = s / (float)cnt - Z[(size_t)t * DZ + 1792 + c];
}
__global__ void k_poollin(const float* pooled, const float* pw, const float* scale, float* Y, int rows) {
    const int i = blockIdx.x * 256 + threadIdx.x; if (i >= rows * 256) return;
    const int t = i / 256, c = i % 256, g = c / 64, d = c % 64; float acc = 0.f;
    for (int cc = 0; cc < 64; ++cc) acc += pooled[(size_t)t * 256 + g * 64 + cc] * pw[((size_t)g * 64 + cc) * 64 + d];
    Y[(size_t)t * D + 768 + c] = acc * scale[c];
}
__global__ void k_scores(const float* q, const float* kv, float* S, int rows) {
    const int i = blockIdx.x * 256 + threadIdx.x; if (i >= rows * 1024) return;
    const int m = i / 1024, h = (i / 256) % 4, j = i % 256; float acc = 0.f;
    const float* qp = q + (size_t)m * D + h * 256; const float* kp = kv + (size_t)j * 2048 + h * 256;
    for (int d = 0; d < 256; ++d) acc += qp[d] * kp[d];
    S[i] = acc * (1.f / 16.f);
}
__global__ void k_softmax256(float* S, int nrows) {
    const int row = blockIdx.x * 4 + threadIdx.x / 64, lane = threadIdx.x % 64; if (row >= nrows) return;
    float* p = S + (size_t)row * 256;
    float v0 = p[lane], v1 = p[lane + 64], v2 = p[lane + 128], v3 = p[lane + 192];
    const float mx = wmax(fmaxf(fmaxf(v0, v1), fmaxf(v2, v3)));
    v0 = expf(v0 - mx); v1 = expf(v1 - mx); v2 = expf(v2 - mx); v3 = expf(v3 - mx);
    const float inv = 1.f / wsum((v0 + v1) + (v2 + v3));
    p[lane] = v0 * inv; p[lane + 64] = v1 * inv; p[lane + 128] = v2 * inv; p[lane + 192] = v3 * inv;
}
__global__ void k_pv(const float* S, const float* kv, float* O, int rows) {
    const int i = blockIdx.x * 256 + threadIdx.x; if (i >= rows * 1024) return;
    const int m = i / 1024, c = i % 1024, h = c / 256; float acc = 0.f;
    const float* sp = S + (size_t)m * 1024 + h * 256;
    for (int j = 0; j < 256; ++j) acc += sp[j] * kv[(size_t)j * 2048 + 1024 + c];
    O[i] = acc;
}

struct In { const float* p[26]; };

static void forward_batch(const In& in, int b, int R, float* X, unsigned char* scratch, hipStream_t st, bool final_norm) {
    const size_t MiB = 1u << 20;
    float* H = (float*)(scratch + 0 * MiB);
    float* C = (float*)(scratch + 16 * MiB);
    float* G = (float*)(scratch + 32 * MiB);
    float* ACT = (float*)(scratch + 120 * MiB);
    float* Z = (float*)(scratch + 32 * MiB);
    float* Y = (float*)(scratch + 64 * MiB);
    float* VN = (float*)(scratch + 80 * MiB);
    float* GLU = (float*)(scratch + 84 * MiB);
    float* CONV = (float*)(scratch + 88 * MiB);
    float* POOL = (float*)(scratch + 92 * MiB);
    float* Q = (float*)(scratch + 96 * MiB);
    float* MEMN = (float*)(scratch + 112 * MiB);
    float* KV = (float*)(scratch + 113 * MiB);
    float* S = (float*)(scratch + 120 * MiB);
    float* O = (float*)(scratch + 136 * MiB);
    auto gemm = [&](const float* A, const float* Wt, float* Cc, int M, int N, int K) {
        hipLaunchKernelGGL(k_gemm, dim3(N / 64, M / 64), dim3(256), 0, st, A, Wt, Cc, M, N, K, K, N, N);
    };
    auto ew = [&](size_t n) { return dim3((unsigned)((n + 255) / 256)); };
    const float* xin = in.p[0] + (size_t)b * SEQ * D;
    hipLaunchKernelGGL(k_copy, ew((size_t)R * D), dim3(256), 0, st, X, xin, (size_t)R * D);
    for (int l = 0; l < 2; ++l) {
        hipLaunchKernelGGL(k_rmsnorm, dim3(R / 4), dim3(256), 0, st, X, in.p[2] + l * D, H, R);
        gemm(H, in.p[3] + (size_t)l * D * 2 * DFF, G, R, 2 * DFF, D);
        hipLaunchKernelGGL(k_swiglu, ew((size_t)R * DFF), dim3(256), 0, st, G, ACT, R);
        gemm(ACT, in.p[4] + (size_t)l * DFF * D, C, R, D, DFF);
        hipLaunchKernelGGL(k_axpy, ew((size_t)R * D), dim3(256), 0, st, X, C, 0.5f, (size_t)R * D);
        hipLaunchKernelGGL(k_rmsnorm, dim3(R / 4), dim3(256), 0, st, X, in.p[5] + l * D, H, R);
        gemm(H, in.p[6] + (size_t)l * D * DZ, Z, R, DZ, D);
        hipLaunchKernelGGL(k_mix_a, ew((size_t)R * 256), dim3(256), 0, st, Z, in.p[7] + l * 3 * 256, Y, R);
        hipLaunchKernelGGL(k_ln256, dim3(R / 4), dim3(256), 0, st, Z + 1024, DZ, in.p[8] + l * 256, (const float*)nullptr, VN, 256, R, 0);
        hipLaunchKernelGGL(k_mix_b, ew((size_t)R * 256), dim3(256), 0, st, Z, VN, in.p[9] + (size_t)l * 4 * 128 * 128, in.p[10] + l * 4 * 128, Y, R);
        hipLaunchKernelGGL(k_glu, ew((size_t)R * 256), dim3(256), 0, st, Z, GLU, R);
        hipLaunchKernelGGL(k_conv31, ew((size_t)R * 256), dim3(256), 0, st, GLU, in.p[11] + l * 31 * 256, CONV, R);
        hipLaunchKernelGGL(k_ln256, dim3(R / 4), dim3(256), 0, st, CONV, 256, in.p[12] + l * 256, in.p[13] + l * 256, Y + 512, D, R, 1);
        hipLaunchKernelGGL(k_pool, ew((size_t)R * 256), dim3(256), 0, st, Z, POOL, R);
        hipLaunchKernelGGL(k_poollin, ew((size_t)R * 256), dim3(256), 0, st, POOL, in.p[14] + (size_t)l * 4 * 64 * 64, in.p[15] + l * 256, Y, R);
        gemm(Y, in.p[16] + (size_t)l * D * D, C, R, D, D);
        hipLaunchKernelGGL(k_axpy, ew((size_t)R * D), dim3(256), 0, st, X, C, 1.0f, (size_t)R * D);
        hipLaunchKernelGGL(k_rmsnorm, dim3(R / 4), dim3(256), 0, st, X, in.p[17] + l * D, H, R);
        hipLaunchKernelGGL(k_rmsnorm, dim3(NMEM / 4), dim3(256), 0, st, in.p[1] + (size_t)b * NMEM * D, in.p[18] + l * D, MEMN, NMEM);
        gemm(H, in.p[19] + (size_t)l * D * D, Q, R, D, D);
        gemm(MEMN, in.p[20] + (size_t)l * D * 2 * D, KV, NMEM, 2 * D, D);
        hipLaunchKernelGGL(k_scores, ew((size_t)R * 1024), dim3(256), 0, st, Q, KV, S, R);
        hipLaunchKernelGGL(k_softmax256, dim3(R * 4 / 4), dim3(256), 0, st, S, R * 4);
        hipLaunchKernelGGL(k_pv, ew((size_t)R * 1024), dim3(256), 0, st, S, KV, O, R);
        gemm(O, in.p[21] + (size_t)l * D * D, C, R, D, D);
        hipLaunchKernelGGL(k_axpy, ew((size_t)R * D), dim3(256), 0, st, X, C, 1.0f, (size_t)R * D);
        hipLaunchKernelGGL(k_rmsnorm, dim3(R / 4), dim3(256), 0, st, X, in.p[22] + l * D, H, R);
        gemm(H, in.p[23] + (size_t)l * D * 2 * DFF, G, R, 2 * DFF, D);
        hipLaunchKernelGGL(k_swiglu, ew((size_t)R * DFF), dim3(256), 0, st, G, ACT, R);
        gemm(ACT, in.p[24] + (size_t)l * DFF * D, C, R, D, DFF);
        hipLaunchKernelGGL(k_axpy, ew((size_t)R * D), dim3(256), 0, st, X, C, 0.5f, (size_t)R * D);
    }
    if (final_norm) hipLaunchKernelGGL(k_rmsnorm, dim3(R / 4), dim3(256), 0, st, X, in.p[25], X, R);
}
}

extern "C" void kernel_launch(void* const* d_in, const int* in_sizes, int n_in, void* d_out, int out_size, void* d_ws, size_t ws_size, hipStream_t stream) {
    if (n_in != 26 || out_size != 4 * 4096 * 1024 || ws_size < (size_t)170 * (1u << 20)) { fprintf(stderr, "kernel_launch: unexpected shapes (n_in %d out %d ws %zu)\n", n_in, out_size, ws_size); return; }
    nv::In in; for (int i = 0; i < 26; ++i) in.p[i] = (const float*)d_in[i];
    for (int b = 0; b < 4; ++b)
        nv::forward_batch(in, b, 4096, (float*)d_out + (size_t)b * 4096 * 1024, (unsigned char*)d_ws, stream, true);
}
```

```cpp
#include <hip/hip_runtime.h>
#include <hip/hip_cooperative_groups.h>
#include <cstdio>
#include <cstdint>
namespace cg = cooperative_groups;
namespace pg8 {
#define PG8_LAS __attribute__((address_space(3)))
typedef unsigned short bf16_t;
typedef short bf16x8 __attribute__((ext_vector_type(8)));
typedef float f32x4 __attribute__((ext_vector_type(4)));
typedef float f32x2 __attribute__((ext_vector_type(2)));
typedef unsigned u32x4 __attribute__((ext_vector_type(4)));
typedef unsigned u32x2 __attribute__((ext_vector_type(2)));
constexpr int BM = 256, BK = 64, HALF = 128, HTB = HALF * BK * 2, STAGE_BYTES = 8 * HTB, NXCD = 8, WGM = 8;

__host__ __device__ __forceinline__ int lds_byte(int r, int c) { const int st = (r >> 4) * 2 + (c >> 5), rr = r & 15, cc = c & 31, ob = rr * 64 + cc * 2; return st * 1024 + (ob ^ (((ob >> 9) & 1) << 5)); }
__host__ __device__ __forceinline__ void stage_rc(int b, int& R, int& C) { const int st = b / 1024, sb = b % 1024, swz = sb ^ (((sb >> 9) & 1) << 5); R = (st >> 1) * 16 + swz / 64; C = (st & 1) * 32 + (swz % 64) / 2; }
__host__ __device__ __forceinline__ int perm32(int rho) { const int n = rho >> 4, i = rho & 15; return 8 * (i >> 2) + 4 * n + (i & 3); }

struct Unit { int pm, pn; };
struct Gemm { const bf16_t* A; const bf16_t* Bt; int lda, ldb, K; long a_pm, a_pn, b_pn, b_pb; };
__device__ __forceinline__ Gemm plain_gemm(const bf16_t* A, const bf16_t* Bt, int K) { Gemm g; g.A = A; g.Bt = Bt; g.lda = K; g.ldb = K; g.K = K; g.a_pm = 256L * K; g.a_pn = 0; g.b_pn = 256L * K; g.b_pb = 0; return g; }

struct StaticOrder {
    int nM, nN, nwg, G, c;
    __host__ __device__ void init(int M, int N, int G_, int c_) { nM = M / BM; nN = N / BM; nwg = nM * nN; G = G_; c = c_; }
    __host__ __device__ bool next(int i, Unit& u) const {
        const long L = (long)i * G + c; if (L >= nwg) return false;
        int wgid = (int)L; { const int q = nwg / NXCD, r = nwg % NXCD, xcd = wgid % NXCD, off = wgid / NXCD; wgid = (xcd < r ? xcd * (q + 1) : r * (q + 1) + (xcd - r) * q) + off; }
        const int nig = WGM * nN, gid = wgid / nig, fm = gid * WGM, gsz = (nM - fm) < WGM ? (nM - fm) : WGM;
        u.pm = fm + ((wgid % nig) % gsz); u.pn = (wgid % nig) / gsz; return true;
    }
};

__device__ __forceinline__ unsigned cvt_pk_bf16(float lo, float hi) { unsigned r; asm volatile("v_cvt_pk_bf16_f32 %0, %1, %2" : "=v"(r) : "v"(lo), "v"(hi)); return r; }

__device__ __forceinline__ float row_rs(const float* ss, int row) {
    const f32x4 a = *(const f32x4*)(ss + (size_t)row * 4);
    const float s = (a[0] + a[1]) + (a[2] + a[3]);
    return 1.0f / sqrtf(s * (1.0f / 1024.0f) + 1e-6f);
}
__device__ __forceinline__ float fast_silu(float g) { return g * __builtin_amdgcn_rcpf(1.0f + __expf(-g)); }


struct EpiBf16 {
    static constexpr bool PERM = true, AFTER_DRAIN = false;
    bf16_t* O; int ldc; const float* ss; float scale;
    __device__ __forceinline__ void operator()(const f32x4 (&acc)[2][2][4][2], const Unit& u, int wr, int wc, int fr, int fq, PG8_LAS unsigned char* spare, int tid) const {
        const int row0 = u.pm * BM + wr * 64 + fr, col0 = u.pn * BM + wc * 32 + 8 * fq;
#pragma unroll
        for (int ai = 0; ai < 2; ++ai)
#pragma unroll
            for (int m = 0; m < 4; ++m) { const int row = row0 + ai * HALF + m * 16; const float sc = ss ? row_rs(ss, row) * scale : scale;
                bf16_t* rowp = O + (size_t)row * ldc + col0;
#pragma unroll
                for (int bj = 0; bj < 2; ++bj) { const f32x4 v0 = acc[ai][bj][m][0] * sc, v1 = acc[ai][bj][m][1] * sc;
                    u32x4 w; w.x = cvt_pk_bf16(v0[0], v0[1]); w.y = cvt_pk_bf16(v0[2], v0[3]); w.z = cvt_pk_bf16(v1[0], v1[1]); w.w = cvt_pk_bf16(v1[2], v1[3]);
                    *(u32x4*)(rowp + bj * HALF) = w; } }
    }
};
struct EpiSwiGLU {
    static constexpr bool PERM = true, AFTER_DRAIN = false;
    bf16_t* O; const float* ss;
    __device__ __forceinline__ void operator()(const f32x4 (&acc)[2][2][4][2], const Unit& u, int wr, int wc, int fr, int fq, PG8_LAS unsigned char* spare, int tid) const {
        const int row0 = u.pm * BM + wr * 64 + fr, col0 = u.pn * HALF + wc * 32 + 8 * fq;
#pragma unroll
        for (int ai = 0; ai < 2; ++ai)
#pragma unroll
            for (int m = 0; m < 4; ++m) { const int row = row0 + ai * HALF + m * 16; const float sc = row_rs(ss, row);
                const f32x4 g0 = acc[ai][0][m][0] * sc, g1 = acc[ai][0][m][1] * sc, u0 = acc[ai][1][m][0] * sc, u1 = acc[ai][1][m][1] * sc;
                u32x4 w; w.x = cvt_pk_bf16(fast_silu(g0[0]) * u0[0], fast_silu(g0[1]) * u0[1]); w.y = cvt_pk_bf16(fast_silu(g0[2]) * u0[2], fast_silu(g0[3]) * u0[3]);
                w.z = cvt_pk_bf16(fast_silu(g1[0]) * u1[0], fast_silu(g1[1]) * u1[1]); w.w = cvt_pk_bf16(fast_silu(g1[2]) * u1[2], fast_silu(g1[3]) * u1[3]);
                *(u32x4*)(O + (size_t)row * 2816 + col0) = w; }
    }
};
struct EpiResid {
    static constexpr bool PERM = false, AFTER_DRAIN = false;
    const float* base; float* out; bf16_t* xb; float* ss; float alpha;
    __device__ __forceinline__ void operator()(const f32x4 (&acc)[2][2][4][2], const Unit& u, int wr, int wc, int fr, int fq, PG8_LAS unsigned char* spare, int tid) const {
        PG8_LAS float* Pq = (PG8_LAS float*)spare;
        const int row0 = u.pm * BM + wr * 64 + fr, col0 = u.pn * BM + wc * 32 + 4 * fq;
#pragma unroll
        for (int ai = 0; ai < 2; ++ai)
#pragma unroll
            for (int m = 0; m < 4; ++m) { const int row = row0 + ai * HALF + m * 16; const size_t off = (size_t)row * 1024 + col0; float q = 0.f;
#pragma unroll
                for (int bj = 0; bj < 2; ++bj)
#pragma unroll
                    for (int n = 0; n < 2; ++n) { const f32x4 b = *(const f32x4*)(base + off + bj * HALF + n * 16); const f32x4 o = b + acc[ai][bj][m][n] * alpha;
                        *(f32x4*)(out + off + bj * HALF + n * 16) = o; u32x2 w; w.x = cvt_pk_bf16(o[0], o[1]); w.y = cvt_pk_bf16(o[2], o[3]);
                        *(u32x2*)(xb + off + bj * HALF + n * 16) = w; q += (o[0] * o[0] + o[1] * o[1]) + (o[2] * o[2] + o[3] * o[3]); }
                q += __shfl_xor(q, 16); q += __shfl_xor(q, 32);
                if (fq == 0) Pq[(ai * HALF + wr * 64 + m * 16 + fr) * 4 + wc] = q;
                if (m & 1) asm volatile("" ::: "memory"); }
        asm volatile("s_waitcnt lgkmcnt(0)" ::: "memory"); __builtin_amdgcn_s_barrier(); asm volatile("" ::: "memory");
        if (tid < 256) { const f32x4 v = *(const PG8_LAS f32x4*)(Pq + tid * 4); ss[(size_t)(u.pm * BM + tid) * 4 + u.pn] = (v[0] + v[1]) + (v[2] + v[3]); }
    }
};
struct EpiSoftmax {
    static constexpr bool PERM = true, AFTER_DRAIN = true;
    bf16_t* P;
    __device__ __forceinline__ void fused(f32x4 (&acc)[2][2][4][2], const Unit& u, int wr, int wc, int fr, int fq, PG8_LAS unsigned char* lds, int wid, int lane) const {
        PG8_LAS float* Pm = (PG8_LAS float*)lds;
        PG8_LAS float* Ps = (PG8_LAS float*)(lds + 4096);
#pragma unroll
        for (int ai = 0; ai < 2; ++ai)
#pragma unroll
            for (int m = 0; m < 4; ++m) { float mx = -3.0e38f;
#pragma unroll
                for (int bj = 0; bj < 2; ++bj)
#pragma unroll
                    for (int n = 0; n < 2; ++n) { const f32x4 x = acc[ai][bj][m][n]; mx = fmaxf(mx, fmaxf(fmaxf(x[0], x[1]), fmaxf(x[2], x[3]))); }
                mx = fmaxf(mx, __shfl_xor(mx, 16)); mx = fmaxf(mx, __shfl_xor(mx, 32));
                if (fq == 0) Pm[(ai * HALF + wr * 64 + m * 16 + fr) * 4 + wc] = mx; }
        asm volatile("s_waitcnt lgkmcnt(0)" ::: "memory"); __builtin_amdgcn_s_barrier(); asm volatile("" ::: "memory");
#pragma unroll
        for (int ai = 0; ai < 2; ++ai)
#pragma unroll
            for (int m = 0; m < 4; ++m) { const int r = ai * HALF + wr * 64 + m * 16 + fr; const f32x4 pm4 = *(const PG8_LAS f32x4*)(Pm + r * 4);
                const float mx = fmaxf(fmaxf(pm4[0], pm4[1]), fmaxf(pm4[2], pm4[3])); float s = 0.f;
#pragma unroll
                for (int bj = 0; bj < 2; ++bj)
#pragma unroll
                    for (int n = 0; n < 2; ++n) { f32x4 x = acc[ai][bj][m][n];
                        x[0] = __builtin_amdgcn_exp2f(x[0] - mx); x[1] = __builtin_amdgcn_exp2f(x[1] - mx); x[2] = __builtin_amdgcn_exp2f(x[2] - mx); x[3] = __builtin_amdgcn_exp2f(x[3] - mx);
                        acc[ai][bj][m][n] = x; s += (x[0] + x[1]) + (x[2] + x[3]); }
                s += __shfl_xor(s, 16); s += __shfl_xor(s, 32);
                if (fq == 0) Ps[r * 4 + wc] = s; }
        asm volatile("s_waitcnt lgkmcnt(0)" ::: "memory"); __builtin_amdgcn_s_barrier(); asm volatile("" ::: "memory");
        const int col0 = u.pn * BM + wc * 32 + 8 * fq;
#pragma unroll
        for (int ai = 0; ai < 2; ++ai)
#pragma unroll
            for (int m = 0; m < 4; ++m) { const int r = ai * HALF + wr * 64 + m * 16 + fr; const f32x4 ps4 = *(const PG8_LAS f32x4*)(Ps + r * 4);
                const float inv = 1.0f / ((ps4[0] + ps4[1]) + (ps4[2] + ps4[3]));
                bf16_t* rowp = P + (size_t)(u.pm * BM + r) * 1024 + col0;
#pragma unroll
                for (int bj = 0; bj < 2; ++bj) { const f32x4 v0 = acc[ai][bj][m][0] * inv, v1 = acc[ai][bj][m][1] * inv;
                    u32x4 w; w.x = cvt_pk_bf16(v0[0], v0[1]); w.y = cvt_pk_bf16(v0[2], v0[3]); w.z = cvt_pk_bf16(v1[0], v1[1]); w.w = cvt_pk_bf16(v1[2], v1[3]);
                    *(u32x4*)(rowp + bj * HALF) = w; } }
        asm volatile("s_waitcnt lgkmcnt(0)" ::: "memory"); __builtin_amdgcn_s_barrier(); asm volatile("" ::: "memory");
    }
};

template <class Epi, class Sched, bool ALIGN_EPI>
__device__ __forceinline__ void gemm_phase(PG8_LAS unsigned char* lds, const Gemm g, const Sched& S, const Epi& E) {
    int tid_ = threadIdx.x; asm volatile("" : "+v"(tid_));
    const int tid = tid_, wid = __builtin_amdgcn_readfirstlane(tid >> 6), lane = tid & 63, wr = wid >> 2, wc = wid & 3, fr = lane & 15, fq = lane >> 4;
    const int K = g.K, nt = K / BK;
    unsigned voffA[2], voffB[2];
#pragma unroll
    for (int i = 0; i < 2; ++i) { int R, C; stage_rc(tid * 16 + i * 8192, R, C); const int Rb = Epi::PERM ? ((R & ~31) + perm32(R & 31)) : R;
        voffA[i] = (unsigned)(R * g.lda + C) * 2u; voffB[i] = (unsigned)(Rb * g.ldb + C) * 2u; }
    const size_t kstep = (size_t)(BK * 2);
    const size_t hstepA = (size_t)HALF * g.lda * 2, hstepB = (size_t)HALF * g.ldb * 2;
    const unsigned ldsw = (unsigned)wid * 1024u;
    const int aoff = lds_byte(wr * 64 + fr, fq * 8), boff = lds_byte(wc * 32 + fr, fq * 8);
#define PG8_SA(b, h) (((b) * 2 + (h)) * HTB)
#define PG8_SB(b, h) ((4 + (b) * 2 + (h)) * HTB)
#define PG8_STAGE(bufoff, gbase, voff) do { _Pragma("unroll") for (int _i = 0; _i < 2; ++_i) \
        __builtin_amdgcn_global_load_lds((const unsigned*)((const char*)(gbase) + (voff)[_i]), (PG8_LAS unsigned*)(lds + (bufoff) + ldsw + _i * 8192), 16, 0, 0); } while (0)
#define PG8_LDA(dst, b, h) do { _Pragma("unroll") for (int m = 0; m < 4; ++m) _Pragma("unroll") for (int k = 0; k < 2; ++k) dst[m][k] = *(const PG8_LAS bf16x8*)(lds + PG8_SA(b, h) + aoff + m * 2048 + k * 1024); } while (0)
#define PG8_LDB(dst, b, h) do { _Pragma("unroll") for (int n = 0; n < 2; ++n) _Pragma("unroll") for (int k = 0; k < 2; ++k) dst[n][k] = *(const PG8_LAS bf16x8*)(lds + PG8_SB(b, h) + boff + n * 2048 + k * 1024); } while (0)
#define PG8_MMA(ai, bj, At, Bt) do { __builtin_amdgcn_s_setprio(1); _Pragma("unroll") for (int m = 0; m < 4; ++m) _Pragma("unroll") for (int n = 0; n < 2; ++n) _Pragma("unroll") for (int k = 0; k < 2; ++k) \
        acc[ai][bj][m][n] = __builtin_amdgcn_mfma_f32_16x16x32_bf16(Bt[n][k], At[m][k], acc[ai][bj][m][n], 0, 0, 0); __builtin_amdgcn_s_setprio(0); } while (0)
#define PG8_WAIT_V(n) asm volatile("s_waitcnt vmcnt(" #n ")" ::: "memory")
#define PG8_WAIT_L(n) asm volatile("s_waitcnt lgkmcnt(" #n ")" ::: "memory")
#define PG8_BAR __builtin_amdgcn_s_barrier()
#define PG8_SCHED __builtin_amdgcn_sched_barrier(0)
#define PG8_APTR(u) ((const char*)g.A + ((size_t)(u).pm * g.a_pm + (size_t)(u).pn * g.a_pn) * 2)
#define PG8_BPTR(u) ((const char*)g.Bt + ((size_t)(u).pn * g.b_pn + (size_t)((u).pm >> 4) * g.b_pb) * 2)
    Unit cur, nxt; int ui = 0;
    if (!S.next(0, cur)) return;
    f32x4 acc[2][2][4][2];
#pragma unroll
    for (int a = 0; a < 2; ++a)
#pragma unroll
        for (int b = 0; b < 2; ++b)
#pragma unroll
            for (int m = 0; m < 4; ++m)
#pragma unroll
                for (int n = 0; n < 2; ++n) acc[a][b][m][n] = (f32x4){0.f, 0.f, 0.f, 0.f};
    bf16x8 At[4][2], B0[2][2], B1[2][2];
    const char* cA = PG8_APTR(cur); const char* cB = PG8_BPTR(cur);
    PG8_STAGE(PG8_SB(0, 0), cB, voffB); PG8_STAGE(PG8_SB(0, 1), cB + hstepB, voffB); PG8_STAGE(PG8_SA(0, 0), cA, voffA); PG8_STAGE(PG8_SA(0, 1), cA + hstepA, voffA);
    if (wr == 1) PG8_BAR;
    PG8_WAIT_V(2); PG8_BAR;
    PG8_STAGE(PG8_SB(1, 0), cB + kstep, voffB); PG8_STAGE(PG8_SA(1, 0), cA + kstep, voffA); PG8_STAGE(PG8_SB(1, 1), cB + hstepB + kstep, voffB);
    PG8_WAIT_V(6); PG8_BAR;
    for (;;) {
        const bool has_next = S.next(ui + 1, nxt);
        const char* nA = has_next ? PG8_APTR(nxt) : cA; const char* nB = has_next ? PG8_BPTR(nxt) : cB;
        for (int t = 0; t < nt; t += 2) {
            const bool last = (t == nt - 2);
            const char* a1 = cA + (size_t)(t + 1) * kstep;
            const char* a2 = last ? nA : cA + (size_t)(t + 2) * kstep; const char* b2 = last ? nB : cB + (size_t)(t + 2) * kstep;
            const char* a3 = a2 + kstep; const char* b3 = b2 + kstep;
            PG8_LDB(B0, 0, 0); PG8_LDB(B1, 0, 1); PG8_SCHED; PG8_LDA(At, 0, 0); PG8_STAGE(PG8_SA(1, 1), a1 + hstepA, voffA);
            PG8_WAIT_V(8); PG8_WAIT_L(0); PG8_BAR; PG8_MMA(0, 0, At, B0); PG8_MMA(0, 1, At, B1); PG8_BAR; PG8_SCHED;
            PG8_LDA(At, 0, 1); PG8_STAGE(PG8_SB(0, 0), b2, voffB); PG8_STAGE(PG8_SB(0, 1), b2 + hstepB, voffB); PG8_STAGE(PG8_SA(0, 0), a2, voffA);
            PG8_WAIT_V(8); PG8_WAIT_L(0); PG8_BAR; PG8_MMA(1, 0, At, B0); PG8_MMA(1, 1, At, B1); PG8_BAR; PG8_SCHED;
            PG8_LDB(B0, 1, 0); PG8_LDB(B1, 1, 1); PG8_SCHED; PG8_LDA(At, 1, 0); PG8_STAGE(PG8_SA(0, 1), a2 + hstepA, voffA);
            PG8_WAIT_V(8); PG8_WAIT_L(0); PG8_BAR; PG8_MMA(0, 0, At, B0); PG8_MMA(0, 1, At, B1); PG8_BAR; PG8_SCHED;
            PG8_LDA(At, 1, 1); PG8_STAGE(PG8_SB(1, 0), b3, voffB); PG8_STAGE(PG8_SB(1, 1), b3 + hstepB, voffB); PG8_STAGE(PG8_SA(1, 0), a3, voffA);
            PG8_WAIT_V(8); PG8_WAIT_L(0); PG8_BAR; PG8_MMA(1, 0, At, B0); PG8_MMA(1, 1, At, B1); PG8_BAR; PG8_SCHED;
        }
        if constexpr (ALIGN_EPI) { if (wr == 0) PG8_BAR; }
        if constexpr (!Epi::AFTER_DRAIN) { E(acc, cur, wr, wc, fr, fq, lds + STAGE_BYTES, tid); }
        if (!has_next) break;
#pragma unroll
        for (int a = 0; a < 2; ++a)
#pragma unroll
            for (int b = 0; b < 2; ++b)
#pragma unroll
                for (int m = 0; m < 4; ++m)
#pragma unroll
                    for (int n = 0; n < 2; ++n) acc[a][b][m][n] = (f32x4){0.f, 0.f, 0.f, 0.f};
        cur = nxt; cA = nA; cB = nB; ++ui;
        if constexpr (ALIGN_EPI) { if (wr == 1) PG8_BAR; }
    }
    PG8_WAIT_V(0);
    if constexpr (!ALIGN_EPI) { if (wr == 0) PG8_BAR; }
    PG8_BAR;
    if constexpr (Epi::AFTER_DRAIN) { E.fused(acc, cur, wr, wc, fr, fq, lds, wid, lane); }
#undef PG8_SA
#undef PG8_SB
#undef PG8_STAGE
#undef PG8_LDA
#undef PG8_LDB
#undef PG8_MMA
#undef PG8_WAIT_V
#undef PG8_WAIT_L
#undef PG8_BAR
#undef PG8_SCHED
#undef PG8_APTR
#undef PG8_BPTR
}
}

namespace mk {
using pg8::bf16_t; using pg8::bf16x8; using pg8::f32x4; using pg8::f32x2; using pg8::u32x4; using pg8::u32x2; using pg8::cvt_pk_bf16;
#define LAS __attribute__((address_space(3)))
constexpr int NWAVES = 8, NTHR = 512;
constexpr int D = 1024, BATCH = 4, SEQ = 4096, M = BATCH * SEQ, DFF = 2816, DZ = 2048, NMEM = 256;
constexpr int LDS_BYTES = 147456, RING_BYTES = 131072;
constexpr size_t MiB = 1u << 20;
constexpr size_t WS_CTL = 0, WS_SS = 1 * MiB, WS_MEMN = 2 * MiB, WS_KB = 6 * MiB, WS_VT = 10 * MiB, WS_W = 14 * MiB, WS_XB = 108 * MiB, WS_R = 140 * MiB, WS_END = 236 * MiB;
constexpr size_t W_LAYER = 47 * MiB;
constexpr size_t W_1IN = 0, W_1OUT = 11 * MiB, W_MIXIN = 16 * MiB + MiB / 2, W_MIXOUT = 20 * MiB + MiB / 2, W_Q = 22 * MiB + MiB / 2, W_KV = 24 * MiB + MiB / 2, W_O = 28 * MiB + MiB / 2,
                 W_2IN = 30 * MiB + MiB / 2, W_2OUT = 41 * MiB + MiB / 2;
constexpr size_t R_ACT = 0, R_Z = 0, R_Y = 64 * MiB, R_Q = 0, R_P = 32 * MiB, R_O = 64 * MiB;
constexpr int NPH = 24;
constexpr float QSCALE = 1.4426950408889634f / 16.0f;

struct Args { const float* in[26]; float* out; unsigned char* ws; int ph_lo, ph_hi; };

__device__ __forceinline__ float wave_sum(float v) {
#pragma unroll
    for (int o = 1; o < 64; o <<= 1) v += __shfl_xor(v, o);
    return v;
}
__device__ __forceinline__ float bf_lo(unsigned u) { return __uint_as_float(u << 16); }
__device__ __forceinline__ float bf_hi(unsigned u) { return __uint_as_float(u & 0xffff0000u); }
#define LDS_WAIT() asm volatile("s_waitcnt lgkmcnt(0)" ::: "memory")

__device__ __forceinline__ void p0_transpose_item(const float* W, int K, int N, bf16_t* WT, int dst_row0, const float* gk, LAS float* scr, int k0, int n0, int lane) {
#pragma unroll 8
    for (int i = 0; i < 32; ++i) { const int kk = 2 * i + (lane >> 5); float v = W[(size_t)(k0 + kk) * N + n0 + (lane & 31)]; if (gk) v *= gk[k0 + kk]; scr[kk * 33 + (lane & 31)] = v; }
    LDS_WAIT(); asm volatile("" ::: "memory");
    const int c = lane & 7;
#pragma unroll
    for (int j = 0; j < 4; ++j) { const int n = (lane >> 3) + 8 * j; const LAS float* s = scr + (8 * c) * 33 + n;
        u32x4 o; o.x = cvt_pk_bf16(s[0 * 33], s[1 * 33]); o.y = cvt_pk_bf16(s[2 * 33], s[3 * 33]); o.z = cvt_pk_bf16(s[4 * 33], s[5 * 33]); o.w = cvt_pk_bf16(s[6 * 33], s[7 * 33]);
        *(u32x4*)(WT + (size_t)(dst_row0 + n) * K + k0 + 8 * c) = o; }
    LDS_WAIT(); asm volatile("" ::: "memory");
}
template <bool SWIGLU>
__device__ __forceinline__ bool p0_matrix(int& r, const float* W, int K, int N, bf16_t* WT, const float* gk, LAS float* scr, int lane) {
    const int nblk = N / 32, items = (K / 64) * nblk;
    if (r >= items) { r -= items; return false; }
    const int kb = r / nblk, nb = r % nblk, n0 = 32 * nb; int dst0 = n0;
    if (SWIGLU) { const int bj = n0 >= DFF ? 1 : 0, j = n0 - bj * DFF; dst0 = 256 * (j >> 7) + 128 * bj + (j & 127); }
    p0_transpose_item(W, K, N, WT, dst0, gk, scr, 64 * kb, n0, lane);
    return true;
}
__device__ __forceinline__ void p0_prologue(const Args& a, LAS unsigned char* lds, int gw, int NGW, int wave, int lane) {
    LAS float* scr = (LAS float*)(lds + wave * 16384);
    unsigned char* ws = a.ws;
    constexpr int ITEMS_L = 2816 + 1408 + 1024 + 512 + 512 + 1024 + 512 + 2816 + 1408;
    for (int it = gw; it < 2 * ITEMS_L; it += NGW) {
        const int l = it / ITEMS_L; int r = it % ITEMS_L;
        unsigned char* wl = ws + WS_W + (size_t)l * W_LAYER;
        if (p0_matrix<true>(r, a.in[3] + (size_t)l * D * 2 * DFF, D, 2 * DFF, (bf16_t*)(wl + W_1IN), a.in[2] + l * D, scr, lane)) continue;
        if (p0_matrix<false>(r, a.in[4] + (size_t)l * DFF * D, DFF, D, (bf16_t*)(wl + W_1OUT), nullptr, scr, lane)) continue;
        if (p0_matrix<false>(r, a.in[6] + (size_t)l * D * DZ, D, DZ, (bf16_t*)(wl + W_MIXIN), a.in[5] + l * D, scr, lane)) continue;
        if (p0_matrix<false>(r, a.in[16] + (size_t)l * D * D, D, D, (bf16_t*)(wl + W_MIXOUT), nullptr, scr, lane)) continue;
        if (p0_matrix<false>(r, a.in[19] + (size_t)l * D * D, D, D, (bf16_t*)(wl + W_Q), a.in[17] + l * D, scr, lane)) continue;
        if (p0_matrix<false>(r, a.in[20] + (size_t)l * D * 2 * D, D, 2 * D, (bf16_t*)(wl + W_KV), nullptr, scr, lane)) continue;
        if (p0_matrix<false>(r, a.in[21] + (size_t)l * D * D, D, D, (bf16_t*)(wl + W_O), nullptr, scr, lane)) continue;
        if (p0_matrix<true>(r, a.in[23] + (size_t)l * D * 2 * DFF, D, 2 * DFF, (bf16_t*)(wl + W_2IN), a.in[22] + l * D, scr, lane)) continue;
        p0_matrix<false>(r, a.in[24] + (size_t)l * DFF * D, DFF, D, (bf16_t*)(wl + W_2OUT), nullptr, scr, lane);
    }
    bf16_t* XB = (bf16_t*)(ws + WS_XB); float* SS = (float*)(ws + WS_SS);
    for (int m = gw; m < M; m += NGW) {
        const f32x4* xr = (const f32x4*)(a.in[0] + (size_t)m * D) + lane; float s = 0.f;
        unsigned long long* o8 = (unsigned long long*)(XB + (size_t)m * D) + lane;
#pragma unroll
        for (int j = 0; j < 4; ++j) { const f32x4 v = xr[64 * j]; s += (v[0] * v[0] + v[1] * v[1]) + (v[2] * v[2] + v[3] * v[3]);
            o8[64 * j] = (unsigned long long)cvt_pk_bf16(v[0], v[1]) | ((unsigned long long)cvt_pk_bf16(v[2], v[3]) << 32); }
        s = wave_sum(s);
        if (lane < 4) SS[(size_t)m * 4 + lane] = lane == 0 ? s : 0.f;
    }
    for (int m = gw; m < 2 * BATCH * NMEM; m += NGW) {
        const int l = m / (BATCH * NMEM), rr = m % (BATCH * NMEM);
        const f32x4* xr = (const f32x4*)(a.in[1] + (size_t)rr * D) + lane; const f32x4* gr = (const f32x4*)(a.in[18] + l * D) + lane; f32x4 v[4]; float s = 0.f;
#pragma unroll
        for (int j = 0; j < 4; ++j) { v[j] = xr[64 * j]; s += (v[j][0] * v[j][0] + v[j][1] * v[j][1]) + (v[j][2] * v[j][2] + v[j][3] * v[j][3]); }
        const float rs = 1.0f / sqrtf(wave_sum(s) * (1.0f / D) + 1e-6f);
        unsigned long long* o8 = (unsigned long long*)((bf16_t*)(ws + WS_MEMN) + (size_t)m * D) + lane;
#pragma unroll
        for (int j = 0; j < 4; ++j) { const f32x4 g = gr[64 * j]; const f32x4 y = v[j] * rs * g;
            o8[64 * j] = (unsigned long long)cvt_pk_bf16(y[0], y[1]) | ((unsigned long long)cvt_pk_bf16(y[2], y[3]) << 32); }
    }
}

__device__ __forceinline__ void mixer_a(const bf16_t* Z, bf16_t* Y, const float* sw, int ch, int tid) {
    const int m0 = ch * 128, t0 = m0 & (SEQ - 1);
    const int cp = tid & 127, tg = tid >> 7, c = 2 * cp;
    const float w0a = sw[c], w0b = sw[c + 1], w1a = sw[256 + c], w1b = sw[256 + c + 1], w2a = sw[512 + c], w2b = sw[512 + c + 1];
    const int ms = m0 + 32 * tg, tpos = t0 + 32 * tg;
    float p2a = 0.f, p2b = 0.f, p1a = 0.f, p1b = 0.f;
    if (tpos >= 2) {
        const bf16_t* z2 = Z + (size_t)(ms - 2) * DZ + c; const bf16_t* z1 = Z + (size_t)(ms - 1) * DZ + c;
        unsigned uc = *(const unsigned*)(z2 + 256), ux = *(const unsigned*)(z2 + 512); p2a = bf_lo(uc) * bf_lo(ux); p2b = bf_hi(uc) * bf_hi(ux);
        uc = *(const unsigned*)(z1 + 256); ux = *(const unsigned*)(z1 + 512); p1a = bf_lo(uc) * bf_lo(ux); p1b = bf_hi(uc) * bf_hi(ux);
    }
#pragma unroll 4
    for (int i = 0; i < 32; ++i) {
        const bf16_t* zr = Z + (size_t)(ms + i) * DZ + c;
        const unsigned ub = *(const unsigned*)zr, uc = *(const unsigned*)(zr + 256), ux = *(const unsigned*)(zr + 512);
        const float pa = bf_lo(uc) * bf_lo(ux), pb = bf_hi(uc) * bf_hi(ux);
        const float ya = bf_lo(ub) * (w0a * p2a + w1a * p1a + w2a * pa), yb = bf_hi(ub) * (w0b * p2b + w1b * p1b + w2b * pb);
        *(unsigned*)(Y + (size_t)(ms + i) * D + c) = cvt_pk_bf16(ya, yb);
        p2a = p1a; p2b = p1b; p1a = pa; p1b = pb;
    }
}
__device__ __forceinline__ void mixer_d(const bf16_t* Z, bf16_t* Y, const float* pw, const float* pscale, LAS unsigned char* lds, int ch, int tid) {
    LAS float* PL = (LAS float*)lds;
    const int m0 = ch * 128, t0 = m0 & (SEQ - 1);
    {
        const int cp = tid & 127, tg = tid >> 7, c = 2 * cp, g = c >> 6, k = 2 << g;
        const int ms = m0 + 32 * tg, tpos = t0 + 32 * tg;
        float sa = 0.f, sb = 0.f;
        for (int j = 1; j < k; ++j) if (tpos - j >= 0) { const unsigned u = *(const unsigned*)(Z + (size_t)(ms - j) * DZ + 1792 + c); sa += bf_lo(u); sb += bf_hi(u); }
        for (int i = 0; i < 32; ++i) {
            const unsigned u = *(const unsigned*)(Z + (size_t)(ms + i) * DZ + 1792 + c); const float wa = bf_lo(u), wb = bf_hi(u);
            sa += wa; sb += wb;
            const int cnt = (tpos + i + 1 < k) ? (tpos + i + 1) : k; const float inv = 1.0f / (float)cnt;
            *(LAS f32x2*)(PL + (32 * tg + i) * 256 + c) = (f32x2){sa * inv - wa, sb * inv - wb};
            if (tpos + i - (k - 1) >= 0) { const unsigned u2 = *(const unsigned*)(Z + (size_t)(ms + i - (k - 1)) * DZ + 1792 + c); sa -= bf_lo(u2); sb -= bf_hi(u2); }
        }
    }
    __syncthreads();
    {
        const int dcol = tid & 255, th = tid >> 8, g = dcol >> 6, d = dcol & 63;
        float w[64];
#pragma unroll
        for (int c = 0; c < 64; ++c) w[c] = pw[((size_t)g * 64 + c) * 64 + d];
        const float sc = pscale[dcol];
        for (int tt = 0; tt < 64; ++tt) { const int t = 64 * th + tt; float acc = 0.f;
#pragma unroll
            for (int c4 = 0; c4 < 16; ++c4) { const f32x4 p = *(const LAS f32x4*)(PL + t * 256 + g * 64 + 4 * c4);
                acc += p[0] * w[4 * c4] + p[1] * w[4 * c4 + 1] + p[2] * w[4 * c4 + 2] + p[3] * w[4 * c4 + 3]; }
            const float y = acc * sc; const float yn = __shfl_down(y, 1);
            if (!(tid & 1)) *(unsigned*)(Y + (size_t)(m0 + t) * D + 768 + dcol) = cvt_pk_bf16(y, yn); }
    }
    __syncthreads();
}
__device__ __forceinline__ void mixer_c(const bf16_t* Z, bf16_t* Y, const float* cw, const float* lng, const float* lnb, LAS unsigned char* lds, int hc, int tid) {
    LAS float* GL = (LAS float*)lds;
    const int m0 = hc * 64, t0 = m0 & (SEQ - 1);
    for (int idx = tid; idx < 94 * 128; idx += NTHR) { const int r = idx >> 7, cp = idx & 127; float ga = 0.f, gb = 0.f;
        if (t0 - 30 + r >= 0) { const bf16_t* zr = Z + (size_t)(m0 - 30 + r) * DZ + 2 * cp; const unsigned ua = *(const unsigned*)(zr + 1280), ug = *(const unsigned*)(zr + 1536);
            ga = bf_lo(ua) * __builtin_amdgcn_rcpf(1.0f + __expf(-bf_lo(ug))); gb = bf_hi(ua) * __builtin_amdgcn_rcpf(1.0f + __expf(-bf_hi(ug))); }
        *(LAS f32x2*)(GL + r * 256 + 2 * cp) = (f32x2){ga, gb}; }
    __syncthreads();
    float outv[2][16];
    const int c = tid & 255;
    {
        float w[31];
#pragma unroll
        for (int k = 0; k < 31; ++k) w[k] = cw[k * 256 + c];
#pragma unroll
        for (int it = 0; it < 2; ++it) { const int tg = (tid >> 8) + 2 * it; float gv[46];
#pragma unroll
            for (int j = 0; j < 46; ++j) gv[j] = GL[(16 * tg + j) * 256 + c];
#pragma unroll
            for (int j = 0; j < 16; ++j) { float acc = 0.f;
#pragma unroll
                for (int k = 0; k < 31; ++k) acc += w[k] * gv[j + k];
                outv[it][j] = acc; } }
    }
    __syncthreads();
#pragma unroll
    for (int it = 0; it < 2; ++it) { const int tg = (tid >> 8) + 2 * it;
#pragma unroll
        for (int j = 0; j < 16; ++j) GL[(16 * tg + j) * 256 + c] = outv[it][j]; }
    __syncthreads();
    {
        const int wave = tid >> 6, lane = tid & 63;
        const f32x4 g4 = *(const f32x4*)(lng + 4 * lane), b4 = *(const f32x4*)(lnb + 4 * lane);
#pragma unroll
        for (int i = 0; i < 8; ++i) { const int tt = wave * 8 + i; f32x4 v = *(const LAS f32x4*)(GL + tt * 256 + 4 * lane);
            const float mu = wave_sum((v[0] + v[1]) + (v[2] + v[3])) * (1.0f / 256.0f); v = v - mu;
            const float var = wave_sum((v[0] * v[0] + v[1] * v[1]) + (v[2] * v[2] + v[3] * v[3])) * (1.0f / 256.0f);
            const float rs = 1.0f / sqrtf(var + 1e-6f); f32x4 y = v * rs * g4 + b4;
            y[0] = pg8::fast_silu(y[0]); y[1] = pg8::fast_silu(y[1]); y[2] = pg8::fast_silu(y[2]); y[3] = pg8::fast_silu(y[3]);
            u32x2 o; o.x = cvt_pk_bf16(y[0], y[1]); o.y = cvt_pk_bf16(y[2], y[3]);
            *(u32x2*)(Y + (size_t)(m0 + tt) * D + 512 + 4 * lane) = o; }
    }
    __syncthreads();
}
__device__ __forceinline__ void mixer_b(const bf16_t* Z, bf16_t* Y, const float* ng, const float* wsg, const float* bs, LAS unsigned char* lds, int ch, int tid) {
    constexpr int VS = 136;
    LAS bf16_t* VT = (LAS bf16_t*)lds;
    const int m0 = ch * 128, wave = tid >> 6, lane = tid & 63, fr = lane & 15, fq = lane >> 4;
    {
        const f32x4 g4 = *(const f32x4*)(ng + 4 * lane);
        unsigned pk[4][8];
#pragma unroll
        for (int j2 = 0; j2 < 8; ++j2) { float y[2][4];
#pragma unroll
            for (int e = 0; e < 2; ++e) { const int s = 16 * wave + 2 * j2 + e; const u32x2 u = *(const u32x2*)(Z + (size_t)(m0 + s) * DZ + 1024 + 4 * lane);
                f32x4 v = (f32x4){bf_lo(u.x), bf_hi(u.x), bf_lo(u.y), bf_hi(u.y)};
                const float mu = wave_sum((v[0] + v[1]) + (v[2] + v[3])) * (1.0f / 256.0f); v = v - mu;
                const float var = wave_sum((v[0] * v[0] + v[1] * v[1]) + (v[2] * v[2] + v[3] * v[3])) * (1.0f / 256.0f);
                const float rs = 1.0f / sqrtf(var + 1e-6f); const f32x4 o = v * rs * g4;
                y[e][0] = o[0]; y[e][1] = o[1]; y[e][2] = o[2]; y[e][3] = o[3]; }
#pragma unroll
            for (int i = 0; i < 4; ++i) pk[i][j2] = cvt_pk_bf16(y[0][i], y[1][i]); }
#pragma unroll
        for (int i = 0; i < 4; ++i) { LAS u32x4* dst = (LAS u32x4*)(VT + (4 * lane + i) * VS + 16 * wave);
            dst[0] = (u32x4){pk[i][0], pk[i][1], pk[i][2], pk[i][3]}; dst[1] = (u32x4){pk[i][4], pk[i][5], pk[i][6], pk[i][7]}; }
    }
    __syncthreads();
    {
        const int h = wave >> 1, th = wave & 1;
        f32x4 acc[4][4];
#pragma unroll
        for (int mt = 0; mt < 4; ++mt)
#pragma unroll
            for (int nt = 0; nt < 4; ++nt) acc[mt][nt] = (f32x4){0.f, 0.f, 0.f, 0.f};
#pragma unroll
        for (int ks = 0; ks < 4; ++ks) {
            if (32 * ks > 64 * th + 63) continue;
            bf16x8 bfr[4];
#pragma unroll
            for (int nt = 0; nt < 4; ++nt) bfr[nt] = *(const LAS bf16x8*)(VT + (h * 64 + 16 * nt + fr) * VS + 32 * ks + 8 * fq);
#pragma unroll
            for (int mt = 0; mt < 4; ++mt) { const int t = 64 * th + 16 * mt + fr, s = 32 * ks + 8 * fq;
                const f32x4* wp = (const f32x4*)(wsg + ((size_t)h * 128 + t) * 128 + s); f32x4 w0 = wp[0], w1 = wp[1];
#pragma unroll
                for (int e = 0; e < 4; ++e) { if (s + e > t) w0[e] = 0.f; if (s + 4 + e > t) w1[e] = 0.f; }
                u32x4 au; au.x = cvt_pk_bf16(w0[0], w0[1]); au.y = cvt_pk_bf16(w0[2], w0[3]); au.z = cvt_pk_bf16(w1[0], w1[1]); au.w = cvt_pk_bf16(w1[2], w1[3]);
                const bf16x8 afr = __builtin_bit_cast(bf16x8, au);
#pragma unroll
                for (int nt = 0; nt < 4; ++nt) acc[mt][nt] = __builtin_amdgcn_mfma_f32_16x16x32_bf16(bfr[nt], afr, acc[mt][nt], 0, 0, 0); }
        }
#pragma unroll
        for (int mt = 0; mt < 4; ++mt) { const int t = 64 * th + 16 * mt + fr; const float bias = bs[h * 128 + t];
#pragma unroll
            for (int nt = 0; nt < 4; ++nt) { const int d0 = h * 64 + 16 * nt + 4 * fq; const u32x2 u = *(const u32x2*)(Z + (size_t)(m0 + t) * DZ + 768 + d0);
                const f32x4 a = acc[mt][nt]; u32x2 o; o.x = cvt_pk_bf16(bf_lo(u.x) * (a[0] + bias), bf_hi(u.x) * (a[1] + bias)); o.y = cvt_pk_bf16(bf_lo(u.y) * (a[2] + bias), bf_hi(u.y) * (a[3] + bias));
                *(u32x2*)(Y + (size_t)(m0 + t) * D + 256 + d0) = o; } }
    }
    __syncthreads();
}

__global__ void __launch_bounds__(NTHR, 2) mk_fwd(Args args) {
    extern __shared__ __attribute__((aligned(16))) unsigned char lds_raw[];
    LAS unsigned char* lds = (LAS unsigned char*)lds_raw;
    const int tid = threadIdx.x, lane = tid & 63, wave = __builtin_amdgcn_readfirstlane(tid >> 6);
    const int G = gridDim.x, bx = blockIdx.x;
    const int gw = bx * NWAVES + wave, NGW = G * NWAVES;
    unsigned char* ws = args.ws;
    float* X = args.out;
    bf16_t* XB = (bf16_t*)(ws + WS_XB); float* SS = (float*)(ws + WS_SS);
    bf16_t* ACT = (bf16_t*)(ws + WS_R + R_ACT); bf16_t* Zb = (bf16_t*)(ws + WS_R + R_Z); bf16_t* Yb = (bf16_t*)(ws + WS_R + R_Y);
    bf16_t* Qb = (bf16_t*)(ws + WS_R + R_Q); bf16_t* Pb = (bf16_t*)(ws + WS_R + R_P); bf16_t* Ob = (bf16_t*)(ws + WS_R + R_O);
    const int lo = args.ph_lo, hi = args.ph_hi;
    cg::grid_group grid = cg::this_grid();
#define IN(k) (lo <= (k) && (k) < hi)
#define SEAM(k) do { if (IN(k) && IN((k) + 1)) grid.sync(); } while (0)

    if (IN(0)) p0_prologue(args, lds, gw, NGW, wave, lane);
    SEAM(0);
#pragma unroll 1
    for (int l = 0; l < 2; ++l) {
        const int pb = 1 + 11 * l;
        unsigned char* wl = ws + WS_W + (size_t)l * W_LAYER;
        if (IN(pb + 0)) {
            { pg8::Gemm g = pg8::plain_gemm(XB, (const bf16_t*)(wl + W_1IN), D); pg8::StaticOrder S; S.init(M, 2 * DFF, G, bx);
              pg8::EpiSwiGLU E{ACT, SS}; pg8::gemm_phase<pg8::EpiSwiGLU, pg8::StaticOrder, true>(lds, g, S, E); }
            if (l == 0) {
                for (int kk = 0; kk < 4; ++kk) { const int ll = kk >> 1, isv = kk & 1; const int c2 = (bx + 2 * G - 128 - 32 * kk) % G;
                    const bf16_t* memn = (const bf16_t*)(ws + WS_MEMN) + (size_t)ll * 1024 * D; const bf16_t* wkv = (const bf16_t*)(ws + WS_W + (size_t)ll * W_LAYER + W_KV);
                    pg8::StaticOrder S; S.init(1024, 1024, G, c2);
                    if (!isv) { pg8::Gemm g = pg8::plain_gemm(memn, wkv, D); pg8::EpiBf16 E{(bf16_t*)(ws + WS_KB) + (size_t)ll * 1024 * 1024, 1024, nullptr, 1.0f};
                        pg8::gemm_phase<pg8::EpiBf16, pg8::StaticOrder, true>(lds, g, S, E); }
                    else { pg8::Gemm g = pg8::plain_gemm(wkv + (size_t)1024 * D, memn, D); pg8::EpiBf16 E{(bf16_t*)(ws + WS_VT) + (size_t)ll * 1024 * 1024, 1024, nullptr, 1.0f};
                        pg8::gemm_phase<pg8::EpiBf16, pg8::StaticOrder, true>(lds, g, S, E); } }
            }
        }
        SEAM(pb + 0);
        if (IN(pb + 1)) { pg8::Gemm g = pg8::plain_gemm(ACT, (const bf16_t*)(wl + W_1OUT), DFF); pg8::StaticOrder S; S.init(M, D, G, bx);
            pg8::EpiResid E{l == 0 ? args.in[0] : X, X, XB, SS, 0.5f}; pg8::gemm_phase<pg8::EpiResid, pg8::StaticOrder, true>(lds, g, S, E); }
        SEAM(pb + 1);
        if (IN(pb + 2)) { pg8::Gemm g = pg8::plain_gemm(XB, (const bf16_t*)(wl + W_MIXIN), D); pg8::StaticOrder S; S.init(M, DZ, G, bx);
            pg8::EpiBf16 E{Zb, DZ, SS, 1.0f}; pg8::gemm_phase<pg8::EpiBf16, pg8::StaticOrder, true>(lds, g, S, E); }
        SEAM(pb + 2);
        if (IN(pb + 3)) {
            for (int u = bx; u < 640; u += G) {
                int ptid = tid; asm volatile("" : "+v"(ptid));
                if (u < 256) mixer_c(Zb, Yb, args.in[11] + l * 31 * 256, args.in[12] + l * 256, args.in[13] + l * 256, lds, u, ptid);
                else if (u < 384) mixer_b(Zb, Yb, args.in[8] + l * 256, args.in[9] + (size_t)l * 4 * 128 * 128, args.in[10] + l * 4 * 128, lds, u - 256, ptid);
                else if (u < 512) mixer_d(Zb, Yb, args.in[14] + (size_t)l * 4 * 64 * 64, args.in[15] + l * 256, lds, u - 384, ptid);
                else mixer_a(Zb, Yb, args.in[7] + l * 3 * 256, u - 512, ptid);
            }
        }
        SEAM(pb + 3);
        if (IN(pb + 4)) { pg8::Gemm g = pg8::plain_gemm(Yb, (const bf16_t*)(wl + W_MIXOUT), D); pg8::StaticOrder S; S.init(M, D, G, bx);
            pg8::EpiResid E{X, X, XB, SS, 1.0f}; pg8::gemm_phase<pg8::EpiResid, pg8::StaticOrder, true>(lds, g, S, E); }
        SEAM(pb + 4);
        if (IN(pb + 5)) { pg8::Gemm g = pg8::plain_gemm(XB, (const bf16_t*)(wl + W_Q), D); pg8::StaticOrder S; S.init(M, D, G, bx);
            pg8::EpiBf16 E{Qb, D, SS, QSCALE}; pg8::gemm_phase<pg8::EpiBf16, pg8::StaticOrder, true>(lds, g, S, E); }
        SEAM(pb + 5);
        if (IN(pb + 6)) { pg8::Gemm g; g.A = Qb; g.Bt = (const bf16_t*)(ws + WS_KB) + (size_t)l * 1024 * 1024; g.lda = 1024; g.ldb = 1024; g.K = 256;
            g.a_pm = 256L * 1024; g.a_pn = 256; g.b_pn = 256; g.b_pb = 256L * 1024;
            pg8::StaticOrder S; S.init(M, D, G, bx); pg8::EpiSoftmax E{Pb}; pg8::gemm_phase<pg8::EpiSoftmax, pg8::StaticOrder, false>(lds, g, S, E); }
        SEAM(pb + 6);
        if (IN(pb + 7)) { pg8::Gemm g; g.A = Pb; g.Bt = (const bf16_t*)(ws + WS_VT) + (size_t)l * 1024 * 1024; g.lda = 1024; g.ldb = 1024; g.K = 256;
            g.a_pm = 256L * 1024; g.a_pn = 256; g.b_pn = 256L * 1024; g.b_pb = 256;
            pg8::StaticOrder S; S.init(M, D, G, bx); pg8::EpiBf16 E{Ob, D, nullptr, 1.0f}; pg8::gemm_phase<pg8::EpiBf16, pg8::StaticOrder, true>(lds, g, S, E); }
        SEAM(pb + 7);
        if (IN(pb + 8)) { pg8::Gemm g = pg8::plain_gemm(Ob, (const bf16_t*)(wl + W_O), D); pg8::StaticOrder S; S.init(M, D, G, bx);
            pg8::EpiResid E{X, X, XB, SS, 1.0f}; pg8::gemm_phase<pg8::EpiResid, pg8::StaticOrder, true>(lds, g, S, E); }
        SEAM(pb + 8);
        if (IN(pb + 9)) { pg8::Gemm g = pg8::plain_gemm(XB, (const bf16_t*)(wl + W_2IN), D); pg8::StaticOrder S; S.init(M, 2 * DFF, G, bx);
            pg8::EpiSwiGLU E{ACT, SS}; pg8::gemm_phase<pg8::EpiSwiGLU, pg8::StaticOrder, true>(lds, g, S, E); }
        SEAM(pb + 9);
        if (IN(pb + 10)) { pg8::Gemm g = pg8::plain_gemm(ACT, (const bf16_t*)(wl + W_2OUT), DFF); pg8::StaticOrder S; S.init(M, D, G, bx);
            pg8::EpiResid E{X, X, XB, SS, 0.5f}; pg8::gemm_phase<pg8::EpiResid, pg8::StaticOrder, true>(lds, g, S, E); }
        SEAM(pb + 10);
    }
    if (IN(23)) {
        const f32x4* gf = (const f32x4*)args.in[25] + lane;
        for (int m = gw; m < M; m += NGW) { const float rs = pg8::row_rs(SS, m); f32x4* xr = (f32x4*)(X + (size_t)m * D) + lane;
#pragma unroll
            for (int j = 0; j < 4; ++j) xr[64 * j] = xr[64 * j] * rs * gf[64 * j]; }
    }
#undef IN
#undef SEAM
}
}
#define MK_MODE 0

#ifndef MK_MODE
#define MK_MODE 0
#endif
extern "C" void kernel_launch(void* const* d_in, const int* in_sizes, int n_in, void* d_out, int out_size, void* d_ws, size_t ws_size, hipStream_t stream) {
    using namespace mk;
    static int grid = 0;
    if (grid == 0) {
        if (n_in != 26 || out_size != M * D || ws_size < WS_END) { fprintf(stderr, "kernel_launch: unexpected shapes (n_in %d out %d ws %zu)\n", n_in, out_size, ws_size); grid = -1; return; }
        int dev = 0, cus = 0, per_cu = 0;
        hipGetDevice(&dev); hipDeviceGetAttribute(&cus, hipDeviceAttributeMultiprocessorCount, dev);
        if (hipFuncSetAttribute((const void*)mk_fwd, hipFuncAttributeMaxDynamicSharedMemorySize, LDS_BYTES) != hipSuccess) { fprintf(stderr, "kernel_launch: hipFuncSetAttribute failed\n"); grid = -1; return; }
        if (hipOccupancyMaxActiveBlocksPerMultiprocessor(&per_cu, (const void*)mk_fwd, NTHR, LDS_BYTES) != hipSuccess || per_cu < 1) { fprintf(stderr, "kernel_launch: occupancy query failed (%d)\n", per_cu); per_cu = 1; }
        (void)hipGetLastError();
        grid = cus * per_cu;
        fprintf(stderr, "kernel_launch: cus %d per_cu %d grid %d\n", cus, per_cu, grid);
    }
    if (grid < 0) return;
    Args a{};
    for (int i = 0; i < 26; ++i) a.in[i] = (const float*)d_in[i];
    a.out = (float*)d_out; a.ws = (unsigned char*)d_ws;
#if MK_MODE == 0
    a.ph_lo = 0; a.ph_hi = NPH;
    void* kargs[] = {&a};
    hipError_t e = hipLaunchCooperativeKernel((const void*)mk_fwd, dim3(grid), dim3(NTHR), kargs, LDS_BYTES, stream);
    if (e != hipSuccess) fprintf(stderr, "kernel_launch: cooperative launch failed: %s (grid %d)\n", hipGetErrorString(e), grid);
#else
    for (int p = 0; p < NPH; ++p) { a.ph_lo = p; a.ph_hi = p + 1; hipLaunchKernelGGL(mk_fwd, dim3(grid), dim3(NTHR), LDS_BYTES, stream, a); }
#endif
}
```

```cpp
#include <hip/hip_runtime.h>
#include <hip/hip_cooperative_groups.h>
#include <cstdio>
#include <cstdint>
namespace cg = cooperative_groups;
namespace pg8 {
#define PG8_LAS __attribute__((address_space(3)))
typedef unsigned short bf16_t;
typedef short bf16x8 __attribute__((ext_vector_type(8)));
typedef float f32x4 __attribute__((ext_vector_type(4)));
typedef float f32x2 __attribute__((ext_vector_type(2)));
typedef unsigned u32x4 __attribute__((ext_vector_type(4)));
typedef unsigned u32x2 __attribute__((ext_vector_type(2)));
constexpr int BM = 256, BK = 64, HALF = 128, HTB = HALF * BK * 2, STAGE_BYTES = 8 * HTB, NXCD = 8, WGM = 8;

__host__ __device__ __forceinline__ int lds_byte(int r, int c) { const int st = (r >> 4) * 2 + (c >> 5), rr = r & 15, cc = c & 31, ob = rr * 64 + cc * 2; return st * 1024 + (ob ^ (((ob >> 9) & 1) << 5)); }
__host__ __device__ __forceinline__ void stage_rc(int b, int& R, int& C) { const int st = b / 1024, sb = b % 1024, swz = sb ^ (((sb >> 9) & 1) << 5); R = (st >> 1) * 16 + swz / 64; C = (st & 1) * 32 + (swz % 64) / 2; }
__host__ __device__ __forceinline__ int perm32(int rho) { const int n = rho >> 4, i = rho & 15; return 8 * (i >> 2) + 4 * n + (i & 3); }

struct Unit { int pm, pn; };
struct Gemm { const bf16_t* A; const bf16_t* Bt; int lda, ldb, K; long a_pm, a_pn, b_pn, b_pb; };
__device__ __forceinline__ Gemm plain_gemm(const bf16_t* A, const bf16_t* Bt, int K) { Gemm g; g.A = A; g.Bt = Bt; g.lda = K; g.ldb = K; g.K = K; g.a_pm = 256L * K; g.a_pn = 0; g.b_pn = 256L * K; g.b_pb = 0; return g; }

struct StaticOrder {
    int nM, nN, nwg, G, c;
    __host__ __device__ void init(int M, int N, int G_, int c_) { nM = M / BM; nN = N / BM; nwg = nM * nN; G = G_; c = c_; }
    __host__ __device__ bool next(int i, Unit& u) const {
        const long L = (long)i * G + c; if (L >= nwg) return false;
        int wgid = (int)L; { const int q = nwg / NXCD, r = nwg % NXCD, xcd = wgid % NXCD, off = wgid / NXCD; wgid = (xcd < r ? xcd * (q + 1) : r * (q + 1) + (xcd - r) * q) + off; }
        const int nig = WGM * nN, gid = wgid / nig, fm = gid * WGM, gsz = (nM - fm) < WGM ? (nM - fm) : WGM;
        u.pm = fm + ((wgid % nig) % gsz); u.pn = (wgid % nig) / gsz; return true;
    }
};

__device__ __forceinline__ unsigned cvt_pk_bf16(float lo, float hi) { unsigned r; asm volatile("v_cvt_pk_bf16_f32 %0, %1, %2" : "=v"(r) : "v"(lo), "v"(hi)); return r; }

__device__ __forceinline__ float row_rs(const float* ss, int row) {
    const f32x4 a = *(const f32x4*)(ss + (size_t)row * 4);
    const float s = (a[0] + a[1]) + (a[2] + a[3]);
    return 1.0f / sqrtf(s * (1.0f / 1024.0f) + 1e-6f);
}
__device__ __forceinline__ float fast_silu(float g) { return g * __builtin_amdgcn_rcpf(1.0f + __expf(-g)); }


struct EpiBf16 {
    static constexpr bool PERM = true, AFTER_DRAIN = false;
    bf16_t* O; int ldc; const float* ss; float scale;
    __device__ __forceinline__ void operator()(const f32x4 (&acc)[2][2][4][2], const Unit& u, int wr, int wc, int fr, int fq, PG8_LAS unsigned char* spare, int tid) const {
        const int row0 = u.pm * BM + wr * 64 + fr, col0 = u.pn * BM + wc * 32 + 8 * fq;
#pragma unroll
        for (int ai = 0; ai < 2; ++ai)
#pragma unroll
            for (int m = 0; m < 4; ++m) { const int row = row0 + ai * HALF + m * 16; const float sc = ss ? row_rs(ss, row) * scale : scale;
                bf16_t* rowp = O + (size_t)row * ldc + col0;
#pragma unroll
                for (int bj = 0; bj < 2; ++bj) { const f32x4 v0 = acc[ai][bj][m][0] * sc, v1 = acc[ai][bj][m][1] * sc;
                    u32x4 w; w.x = cvt_pk_bf16(v0[0], v0[1]); w.y = cvt_pk_bf16(v0[2], v0[3]); w.z = cvt_pk_bf16(v1[0], v1[1]); w.w = cvt_pk_bf16(v1[2], v1[3]);
                    *(u32x4*)(rowp + bj * HALF) = w; } }
    }
};
struct EpiSwiGLU {
    static constexpr bool PERM = true, AFTER_DRAIN = false;
    bf16_t* O; const float* ss;
    __device__ __forceinline__ void operator()(const f32x4 (&acc)[2][2][4][2], const Unit& u, int wr, int wc, int fr, int fq, PG8_LAS unsigned char* spare, int tid) const {
        const int row0 = u.pm * BM + wr * 64 + fr, col0 = u.pn * HALF + wc * 32 + 8 * fq;
#pragma unroll
        for (int ai = 0; ai < 2; ++ai)
#pragma unroll
            for (int m = 0; m < 4; ++m) { const int row = row0 + ai * HALF + m * 16; const float sc = row_rs(ss, row);
                const f32x4 g0 = acc[ai][0][m][0] * sc, g1 = acc[ai][0][m][1] * sc, u0 = acc[ai][1][m][0] * sc, u1 = acc[ai][1][m][1] * sc;
                u32x4 w; w.x = cvt_pk_bf16(fast_silu(g0[0]) * u0[0], fast_silu(g0[1]) * u0[1]); w.y = cvt_pk_bf16(fast_silu(g0[2]) * u0[2], fast_silu(g0[3]) * u0[3]);
                w.z = cvt_pk_bf16(fast_silu(g1[0]) * u1[0], fast_silu(g1[1]) * u1[1]); w.w = cvt_pk_bf16(fast_silu(g1[2]) * u1[2], fast_silu(g1[3]) * u1[3]);
                *(u32x4*)(O + (size_t)row * 2816 + col0) = w; }
    }
};
struct EpiResid {
    static constexpr bool PERM = false, AFTER_DRAIN = false;
    const float* base; float* out; bf16_t* xb; float* ss; float alpha;
    __device__ __forceinline__ void operator()(const f32x4 (&acc)[2][2][4][2], const Unit& u, int wr, int wc, int fr, int fq, PG8_LAS unsigned char* spare, int tid) const {
        PG8_LAS float* Pq = (PG8_LAS float*)spare;
        const int row0 = u.pm * BM + wr * 64 + fr, col0 = u.pn * BM + wc * 32 + 4 * fq;
#pragma unroll
        for (int ai = 0; ai < 2; ++ai)
#pragma unroll
            for (int m = 0; m < 4; ++m) { const int row = row0 + ai * HALF + m * 16; const size_t off = (size_t)row * 1024 + col0; float q = 0.f;
#pragma unroll
                for (int bj = 0; bj < 2; ++bj)
#pragma unroll
                    for (int n = 0; n < 2; ++n) { const f32x4 b = *(const f32x4*)(base + off + bj * HALF + n * 16); const f32x4 o = b + acc[ai][bj][m][n] * alpha;
                        *(f32x4*)(out + off + bj * HALF + n * 16) = o; u32x2 w; w.x = cvt_pk_bf16(o[0], o[1]); w.y = cvt_pk_bf16(o[2], o[3]);
                        *(u32x2*)(xb + off + bj * HALF + n * 16) = w; q += (o[0] * o[0] + o[1] * o[1]) + (o[2] * o[2] + o[3] * o[3]); }
                q += __shfl_xor(q, 16); q += __shfl_xor(q, 32);
                if (fq == 0) Pq[(ai * HALF + wr * 64 + m * 16 + fr) * 4 + wc] = q;
                if (m & 1) asm volatile("" ::: "memory"); }
        asm volatile("s_waitcnt lgkmcnt(0)" ::: "memory"); __builtin_amdgcn_s_barrier(); asm volatile("" ::: "memory");
        if (tid < 256) { const f32x4 v = *(const PG8_LAS f32x4*)(Pq + tid * 4); ss[(size_t)(u.pm * BM + tid) * 4 + u.pn] = (v[0] + v[1]) + (v[2] + v[3]); }
    }
};
struct EpiSoftmax {
    static constexpr bool PERM = true, AFTER_DRAIN = true;
    bf16_t* P;
    __device__ __forceinline__ void fused(f32x4 (&acc)[2][2][4][2], const Unit& u, int wr, int wc, int fr, int fq, PG8_LAS unsigned char* lds, int wid, int lane) const {
        PG8_LAS float* Pm = (PG8_LAS float*)lds;
        PG8_LAS float* Ps = (PG8_LAS float*)(lds + 4096);
#pragma unroll
        for (int ai = 0; ai < 2; ++ai)
#pragma unroll
            for (int m = 0; m < 4; ++m) { float mx = -3.0e38f;
#pragma unroll
                for (int bj = 0; bj < 2; ++bj)
#pragma unroll
                    for (int n = 0; n < 2; ++n) { const f32x4 x = acc[ai][bj][m][n]; mx = fmaxf(mx, fmaxf(fmaxf(x[0], x[1]), fmaxf(x[2], x[3]))); }
                mx = fmaxf(mx, __shfl_xor(mx, 16)); mx = fmaxf(mx, __shfl_xor(mx, 32));
                if (fq == 0) Pm[(ai * HALF + wr * 64 + m * 16 + fr) * 4 + wc] = mx; }
        asm volatile("s_waitcnt lgkmcnt(0)" ::: "memory"); __builtin_amdgcn_s_barrier(); asm volatile("" ::: "memory");
#pragma unroll
        for (int ai = 0; ai < 2; ++ai)
#pragma unroll
            for (int m = 0; m < 4; ++m) { const int r = ai * HALF + wr * 64 + m * 16 + fr; const f32x4 pm4 = *(const PG8_LAS f32x4*)(Pm + r * 4);
                const float mx = fmaxf(fmaxf(pm4[0], pm4[1]), fmaxf(pm4[2], pm4[3])); float s = 0.f;
#pragma unroll
                for (int bj = 0; bj < 2; ++bj)
#pragma unroll
                    for (int n = 0; n < 2; ++n) { f32x4 x = acc[ai][bj][m][n];
                        x[0] = __builtin_amdgcn_exp2f(x[0] - mx); x[1] = __builtin_amdgcn_exp2f(x[1] - mx); x[2] = __builtin_amdgcn_exp2f(x[2] - mx); x[3] = __builtin_amdgcn_exp2f(x[3] - mx);
                        acc[ai][bj][m][n] = x; s += (x[0] + x[1]) + (x[2] + x[3]); }
                s += __shfl_xor(s, 16); s += __shfl_xor(s, 32);
                if (fq == 0) Ps[r * 4 + wc] = s; }
        asm volatile("s_waitcnt lgkmcnt(0)" ::: "memory"); __builtin_amdgcn_s_barrier(); asm volatile("" ::: "memory");
        const int col0 = u.pn * BM + wc * 32 + 8 * fq;
#pragma unroll
        for (int ai = 0; ai < 2; ++ai)
#pragma unroll
            for (int m = 0; m < 4; ++m) { const int r = ai * HALF + wr * 64 + m * 16 + fr; const f32x4 ps4 = *(const PG8_LAS f32x4*)(Ps + r * 4);
                const float inv = 1.0f / ((ps4[0] + ps4[1]) + (ps4[2] + ps4[3]));
                bf16_t* rowp = P + (size_t)(u.pm * BM + r) * 1024 + col0;
#pragma unroll
                for (int bj = 0; bj < 2; ++bj) { const f32x4 v0 = acc[ai][bj][m][0] * inv, v1 = acc[ai][bj][m][1] * inv;
                    u32x4 w; w.x = cvt_pk_bf16(v0[0], v0[1]); w.y = cvt_pk_bf16(v0[2], v0[3]); w.z = cvt_pk_bf16(v1[0], v1[1]); w.w = cvt_pk_bf16(v1[2], v1[3]);
                    *(u32x4*)(rowp + bj * HALF) = w; } }
        asm volatile("s_waitcnt lgkmcnt(0)" ::: "memory"); __builtin_amdgcn_s_barrier(); asm volatile("" ::: "memory");
    }
};

template <class Epi, class Sched, bool ALIGN_EPI>
__device__ __forceinline__ void gemm_phase(PG8_LAS unsigned char* lds, const Gemm g, const Sched& S, const Epi& E) {
    int tid_ = threadIdx.x; asm volatile("" : "+v"(tid_));
    const int tid = tid_, wid = __builtin_amdgcn_readfirstlane(tid >> 6), lane = tid & 63, wr = wid >> 2, wc = wid & 3, fr = lane & 15, fq = lane >> 4;
    const int K = g.K, nt = K / BK;
    unsigned voffA[2], voffB[2];
#pragma unroll
    for (int i = 0; i < 2; ++i) { int R, C; stage_rc(tid * 16 + i * 8192, R, C); const int Rb = Epi::PERM ? ((R & ~31) + perm32(R & 31)) : R;
        voffA[i] = (unsigned)(R * g.lda + C) * 2u; voffB[i] = (unsigned)(Rb * g.ldb + C) * 2u; }
    const size_t kstep = (size_t)(BK * 2);
    const size_t hstepA = (size_t)HALF * g.lda * 2, hstepB = (size_t)HALF * g.ldb * 2;
    const unsigned ldsw = (unsigned)wid * 1024u;
    const int aoff = lds_byte(wr * 64 + fr, fq * 8), boff = lds_byte(wc * 32 + fr, fq * 8);
#define PG8_SA(b, h) (((b) * 2 + (h)) * HTB)
#define PG8_SB(b, h) ((4 + (b) * 2 + (h)) * HTB)
#define PG8_STAGE(bufoff, gbase, voff) do { _Pragma("unroll") for (int _i = 0; _i < 2; ++_i) \
        __builtin_amdgcn_global_load_lds((const unsigned*)((const char*)(gbase) + (voff)[_i]), (PG8_LAS unsigned*)(lds + (bufoff) + ldsw + _i * 8192), 16, 0, 0); } while (0)
#define PG8_LDA(dst, b, h) do { _Pragma("unroll") for (int m = 0; m < 4; ++m) _Pragma("unroll") for (int k = 0; k < 2; ++k) dst[m][k] = *(const PG8_LAS bf16x8*)(lds + PG8_SA(b, h) + aoff + m * 2048 + k * 1024); } while (0)
#define PG8_LDB(dst, b, h) do { _Pragma("unroll") for (int n = 0; n < 2; ++n) _Pragma("unroll") for (int k = 0; k < 2; ++k) dst[n][k] = *(const PG8_LAS bf16x8*)(lds + PG8_SB(b, h) + boff + n * 2048 + k * 1024); } while (0)
#define PG8_MMA(ai, bj, At, Bt) do { __builtin_amdgcn_s_setprio(1); _Pragma("unroll") for (int m = 0; m < 4; ++m) _Pragma("unroll") for (int n = 0; n < 2; ++n) _Pragma("unroll") for (int k = 0; k < 2; ++k) \
        acc[ai][bj][m][n] = __builtin_amdgcn_mfma_f32_16x16x32_bf16(Bt[n][k], At[m][k], acc[ai][bj][m][n], 0, 0, 0); __builtin_amdgcn_s_setprio(0); } while (0)
#define PG8_WAIT_V(n) asm volatile("s_waitcnt vmcnt(" #n ")" ::: "memory")
#define PG8_WAIT_L(n) asm volatile("s_waitcnt lgkmcnt(" #n ")" ::: "memory")
#define PG8_BAR __builtin_amdgcn_s_barrier()
#define PG8_SCHED __builtin_amdgcn_sched_barrier(0)
#define PG8_APTR(u) ((const char*)g.A + ((size_t)(u).pm * g.a_pm + (size_t)(u).pn * g.a_pn) * 2)
#define PG8_BPTR(u) ((const char*)g.Bt + ((size_t)(u).pn * g.b_pn + (size_t)((u).pm >> 4) * g.b_pb) * 2)
    Unit cur, nxt; int ui = 0;
    if (!S.next(0, cur)) return;
    f32x4 acc[2][2][4][2];
#pragma unroll
    for (int a = 0; a < 2; ++a)
#pragma unroll
        for (int b = 0; b < 2; ++b)
#pragma unroll
            for (int m = 0; m < 4; ++m)
#pragma unroll
                for (int n = 0; n < 2; ++n) acc[a][b][m][n] = (f32x4){0.f, 0.f, 0.f, 0.f};
    bf16x8 At[4][2], B0[2][2], B1[2][2];
    const char* cA = PG8_APTR(cur); const char* cB = PG8_BPTR(cur);
    PG8_STAGE(PG8_SB(0, 0), cB, voffB); PG8_STAGE(PG8_SB(0, 1), cB + hstepB, voffB); PG8_STAGE(PG8_SA(0, 0), cA, voffA); PG8_STAGE(PG8_SA(0, 1), cA + hstepA, voffA);
    if (wr == 1) PG8_BAR;
    PG8_WAIT_V(2); PG8_BAR;
    PG8_STAGE(PG8_SB(1, 0), cB + kstep, voffB); PG8_STAGE(PG8_SA(1, 0), cA + kstep, voffA); PG8_STAGE(PG8_SB(1, 1), cB + hstepB + kstep, voffB);
    PG8_WAIT_V(6); PG8_BAR;
    for (;;) {
        const bool has_next = S.next(ui + 1, nxt);
        const char* nA = has_next ? PG8_APTR(nxt) : cA; const char* nB = has_next ? PG8_BPTR(nxt) : cB;
        for (int t = 0; t < nt; t += 2) {
            const bool last = (t == nt - 2);
            const char* a1 = cA + (size_t)(t + 1) * kstep;
            const char* a2 = last ? nA : cA + (size_t)(t + 2) * kstep; const char* b2 = last ? nB : cB + (size_t)(t + 2) * kstep;
            const char* a3 = a2 + kstep; const char* b3 = b2 + kstep;
            PG8_LDB(B0, 0, 0); PG8_LDB(B1, 0, 1); PG8_SCHED; PG8_LDA(At, 0, 0); PG8_STAGE(PG8_SA(1, 1), a1 + hstepA, voffA);
            PG8_WAIT_V(8); PG8_WAIT_L(0); PG8_BAR; PG8_MMA(0, 0, At, B0); PG8_MMA(0, 1, At, B1); PG8_BAR; PG8_SCHED;
            PG8_LDA(At, 0, 1); PG8_STAGE(PG8_SB(0, 0), b2, voffB); PG8_STAGE(PG8_SB(0, 1), b2 + hstepB, voffB); PG8_STAGE(PG8_SA(0, 0), a2, voffA);
            PG8_WAIT_V(8); PG8_WAIT_L(0); PG8_BAR; PG8_MMA(1, 0, At, B0); PG8_MMA(1, 1, At, B1); PG8_BAR; PG8_SCHED;
            PG8_LDB(B0, 1, 0); PG8_LDB(B1, 1, 1); PG8_SCHED; PG8_LDA(At, 1, 0); PG8_STAGE(PG8_SA(0, 1), a2 + hstepA, voffA);
            PG8_WAIT_V(8); PG8_WAIT_L(0); PG8_BAR; PG8_MMA(0, 0, At, B0); PG8_MMA(0, 1, At, B1); PG8_BAR; PG8_SCHED;
            PG8_LDA(At, 1, 1); PG8_STAGE(PG8_SB(1, 0), b3, voffB); PG8_STAGE(PG8_SB(1, 1), b3 + hstepB, voffB); PG8_STAGE(PG8_SA(1, 0), a3, voffA);
            PG8_WAIT_V(8); PG8_WAIT_L(0); PG8_BAR; PG8_MMA(1, 0, At, B0); PG8_MMA(1, 1, At, B1); PG8_BAR; PG8_SCHED;
        }
        if constexpr (ALIGN_EPI) { if (wr == 0) PG8_BAR; }
        if constexpr (!Epi::AFTER_DRAIN) { E(acc, cur, wr, wc, fr, fq, lds + STAGE_BYTES, tid); }
        if (!has_next) break;
#pragma unroll
        for (int a = 0; a < 2; ++a)
#pragma unroll
            for (int b = 0; b < 2; ++b)
#pragma unroll
                for (int m = 0; m < 4; ++m)
#pragma unroll
                    for (int n = 0; n < 2; ++n) acc[a][b][m][n] = (f32x4){0.f, 0.f, 0.f, 0.f};
        cur = nxt; cA = nA; cB = nB; ++ui;
        if constexpr (ALIGN_EPI) { if (wr == 1) PG8_BAR; }
    }
    PG8_WAIT_V(0);
    if constexpr (!ALIGN_EPI) { if (wr == 0) PG8_BAR; }
    PG8_BAR;
    if constexpr (Epi::AFTER_DRAIN) { E.fused(acc, cur, wr, wc, fr, fq, lds, wid, lane); }
#undef PG8_SA
#undef PG8_SB
#undef PG8_STAGE
#undef PG8_LDA
#undef PG8_LDB
#undef PG8_MMA
#undef PG8_WAIT_V
#undef PG8_WAIT_L
#undef PG8_BAR
#undef PG8_SCHED
#undef PG8_APTR
#undef PG8_BPTR
}
}

#ifndef PROBE_MASK
#define PROBE_MASK 0
#endif
namespace mk {
using pg8::bf16_t; using pg8::bf16x8; using pg8::f32x4; using pg8::f32x2; using pg8::u32x4; using pg8::u32x2; using pg8::cvt_pk_bf16;
#define LAS __attribute__((address_space(3)))
constexpr int NWAVES = 8, NTHR = 512;
constexpr int D = 1024, BATCH = 4, SEQ = 4096, M = BATCH * SEQ, DFF = 2816, DZ = 2048, NMEM = 256;
constexpr int LDS_BYTES = 147456, RING_BYTES = 131072;
constexpr size_t MiB = 1u << 20;
constexpr size_t WS_CTL = 0, WS_SS = 1 * MiB, WS_MEMN = 2 * MiB, WS_KB = 6 * MiB, WS_VT = 10 * MiB, WS_W = 14 * MiB, WS_XB = 108 * MiB, WS_R = 140 * MiB, WS_END = 236 * MiB;
constexpr size_t W_LAYER = 47 * MiB;
constexpr size_t W_1IN = 0, W_1OUT = 11 * MiB, W_MIXIN = 16 * MiB + MiB / 2, W_MIXOUT = 20 * MiB + MiB / 2, W_Q = 22 * MiB + MiB / 2, W_KV = 24 * MiB + MiB / 2, W_O = 28 * MiB + MiB / 2,
                 W_2IN = 30 * MiB + MiB / 2, W_2OUT = 41 * MiB + MiB / 2;
constexpr size_t R_ACT = 0, R_Z = 0, R_Y = 64 * MiB, R_Q = 0, R_P = 32 * MiB, R_O = 64 * MiB;
constexpr int NPH = 24;
constexpr float QSCALE = 1.4426950408889634f / 16.0f;

struct Args { const float* in[26]; float* out; unsigned char* ws; int ph_lo, ph_hi; };

__device__ __forceinline__ float wave_sum(float v) {
#pragma unroll
    for (int o = 1; o < 64; o <<= 1) v += __shfl_xor(v, o);
    return v;
}
__device__ __forceinline__ float bf_lo(unsigned u) { return __uint_as_float(u << 16); }
__device__ __forceinline__ float bf_hi(unsigned u) { return __uint_as_float(u & 0xffff0000u); }
#define LDS_WAIT() asm volatile("s_waitcnt lgkmcnt(0)" ::: "memory")


#define XB_TMO      128
#define XB_XCNT(j)  (256  + 64 * (j))
#define XB_XSUB(j)  (1280 + 64 * (j))
#define XB_XGEN(j)  (2304 + 64 * (j))
#define XB_TOP      3328
#define XB_TOPGEN   3392
#define XCD_BAR_WORDS 3456
#define XB_SPIN_CAP (1u << 20)
__device__ __forceinline__ unsigned xb_ld(unsigned* p)              { return __hip_atomic_load(p, __ATOMIC_RELAXED, __HIP_MEMORY_SCOPE_AGENT); }
__device__ __forceinline__ unsigned xb_add(unsigned* p, unsigned v) { return __hip_atomic_fetch_add(p, v, __ATOMIC_RELAXED, __HIP_MEMORY_SCOPE_AGENT); }
__device__ __forceinline__ unsigned xb_xcc_id() { return (unsigned)__builtin_amdgcn_s_getreg((3 << 11) | 20) & 0xFu; }
#define XB_SPIN(cond, bar) do { unsigned _sp = 0; while (cond) { __builtin_amdgcn_s_sleep(1); \
    if ((++_sp & 255u) == 0u) { if (xb_ld(&(bar)[XB_TMO])) break; if (_sp > XB_SPIN_CAP) { atomicAdd(&(bar)[XB_TMO], 1u); break; } } } } while (0)
struct XcdBarrier { unsigned* bar; unsigned x; volatile LAS unsigned* st; };
__device__ __forceinline__ XcdBarrier xcd_barrier_post(unsigned* bar, volatile LAS unsigned* st) {
    XcdBarrier b; b.bar = bar; b.x = xb_xcc_id(); b.st = st;
    if (threadIdx.x == 0) (void)xb_add(&bar[XB_XCNT(b.x)], 1u);
    return b;
}
__device__ __forceinline__ void xcd_barrier_complete(unsigned* bar, unsigned x, unsigned& nloc, unsigned& nx) {
    const unsigned G = gridDim.x * gridDim.y * gridDim.z;
    unsigned sum, cnt, mine, sp = 0u;
    for (;;) {
        sum = 0u; cnt = 0u; mine = 0u;
#pragma unroll
        for (unsigned j = 0; j < 16; ++j) { const unsigned c = xb_ld(&bar[XB_XCNT(j)]); sum += c; cnt += (c > 0u) ? 1u : 0u; mine = (j == x) ? c : mine; }
        if (sum == G) break;
        __builtin_amdgcn_s_sleep(1);
        if ((++sp & 255u) == 0u) { if (xb_ld(&bar[XB_TMO])) break; if (sp > XB_SPIN_CAP) { atomicAdd(&bar[XB_TMO], 1u); break; } }
    }
    nloc = mine > 0u ? mine : 1u; nx = cnt > 0u ? cnt : 1u;
}
__device__ __forceinline__ void xcd_barrier(const XcdBarrier& b) {
    asm volatile("s_waitcnt vmcnt(0)" ::: "memory");
    __syncthreads();
    if (threadIdx.x == 0) {
        unsigned* bar = b.bar;
        __builtin_amdgcn_s_waitcnt(0);
        unsigned nloc = b.st[0], nx = b.st[1];
        if (nloc == 0u) { xcd_barrier_complete(bar, b.x, nloc, nx); b.st[0] = nloc; b.st[1] = nx; }
        const unsigned old = xb_add(&bar[XB_XSUB(b.x)], 1u);
        const unsigned gen = old / nloc;
        if (old + 1u == (gen + 1u) * nloc) {
            __builtin_amdgcn_fence(__ATOMIC_RELEASE, "agent");
            asm volatile("s_waitcnt vmcnt(0)" ::: "memory");
            const unsigned og = xb_add(&bar[XB_TOP], 1u);
            const unsigned tg = og / nx;
            if (og + 1u == (tg + 1u) * nx) xb_add(&bar[XB_TOPGEN], 1u);
            else XB_SPIN(xb_ld(&bar[XB_TOPGEN]) == tg, bar);
            __builtin_amdgcn_fence(__ATOMIC_ACQUIRE, "agent");
            xb_add(&bar[XB_XGEN(b.x)], 1u);
            asm volatile("s_waitcnt vmcnt(0)" ::: "memory");
        } else {
            XB_SPIN(xb_ld(&bar[XB_XGEN(b.x)]) == gen, bar);
            __builtin_amdgcn_fence(__ATOMIC_ACQUIRE, "agent");
            asm volatile("s_waitcnt vmcnt(0)" ::: "memory");
        }
    }
    __syncthreads();
}

__device__ __forceinline__ void p0_transpose_item(const float* W, int K, int N, bf16_t* WT, int dst_row0, const float* gk, LAS float* scr, int k0, int n0, int lane) {
#pragma unroll 8
    for (int i = 0; i < 32; ++i) { const int kk = 2 * i + (lane >> 5); float v = W[(size_t)(k0 + kk) * N + n0 + (lane & 31)]; if (gk) v *= gk[k0 + kk]; scr[kk * 33 + (lane & 31)] = v; }
    LDS_WAIT(); asm volatile("" ::: "memory");
    const int c = lane & 7;
#pragma unroll
    for (int j = 0; j < 4; ++j) { const int n = (lane >> 3) + 8 * j; const LAS float* s = scr + (8 * c) * 33 + n;
        u32x4 o; o.x = cvt_pk_bf16(s[0 * 33], s[1 * 33]); o.y = cvt_pk_bf16(s[2 * 33], s[3 * 33]); o.z = cvt_pk_bf16(s[4 * 33], s[5 * 33]); o.w = cvt_pk_bf16(s[6 * 33], s[7 * 33]);
        *(u32x4*)(WT + (size_t)(dst_row0 + n) * K + k0 + 8 * c) = o; }
    LDS_WAIT(); asm volatile("" ::: "memory");
}
template <bool SWIGLU>
__device__ __forceinline__ bool p0_matrix(int& r, const float* W, int K, int N, bf16_t* WT, const float* gk, LAS float* scr, int lane) {
    const int nblk = N / 32, items = (K / 64) * nblk;
    if (r >= items) { r -= items; return false; }
    const int kb = r / nblk, nb = r % nblk, n0 = 32 * nb; int dst0 = n0;
    if (SWIGLU) { const int bj = n0 >= DFF ? 1 : 0, j = n0 - bj * DFF; dst0 = 256 * (j >> 7) + 128 * bj + (j & 127); }
    p0_transpose_item(W, K, N, WT, dst0, gk, scr, 64 * kb, n0, lane);
    return true;
}
__device__ __forceinline__ void p0_prologue(const Args& a, LAS unsigned char* lds, int gw, int NGW, int wave, int lane) {
    LAS float* scr = (LAS float*)(lds + wave * 16384);
    unsigned char* ws = a.ws;
    constexpr int ITEMS_L = 2816 + 1408 + 1024 + 512 + 512 + 1024 + 512 + 2816 + 1408;
    for (int it = gw; it < 2 * ITEMS_L; it += NGW) {
        const int l = it / ITEMS_L; int r = it % ITEMS_L;
        unsigned char* wl = ws + WS_W + (size_t)l * W_LAYER;
        if (p0_matrix<true>(r, a.in[3] + (size_t)l * D * 2 * DFF, D, 2 * DFF, (bf16_t*)(wl + W_1IN), a.in[2] + l * D, scr, lane)) continue;
        if (p0_matrix<false>(r, a.in[4] + (size_t)l * DFF * D, DFF, D, (bf16_t*)(wl + W_1OUT), nullptr, scr, lane)) continue;
        if (p0_matrix<false>(r, a.in[6] + (size_t)l * D * DZ, D, DZ, (bf16_t*)(wl + W_MIXIN), a.in[5] + l * D, scr, lane)) continue;
        if (p0_matrix<false>(r, a.in[16] + (size_t)l * D * D, D, D, (bf16_t*)(wl + W_MIXOUT), nullptr, scr, lane)) continue;
        if (p0_matrix<false>(r, a.in[19] + (size_t)l * D * D, D, D, (bf16_t*)(wl + W_Q), a.in[17] + l * D, scr, lane)) continue;
        if (p0_matrix<false>(r, a.in[20] + (size_t)l * D * 2 * D, D, 2 * D, (bf16_t*)(wl + W_KV), nullptr, scr, lane)) continue;
        if (p0_matrix<false>(r, a.in[21] + (size_t)l * D * D, D, D, (bf16_t*)(wl + W_O), nullptr, scr, lane)) continue;
        if (p0_matrix<true>(r, a.in[23] + (size_t)l * D * 2 * DFF, D, 2 * DFF, (bf16_t*)(wl + W_2IN), a.in[22] + l * D, scr, lane)) continue;
        p0_matrix<false>(r, a.in[24] + (size_t)l * DFF * D, DFF, D, (bf16_t*)(wl + W_2OUT), nullptr, scr, lane);
    }
    bf16_t* XB = (bf16_t*)(ws + WS_XB); float* SS = (float*)(ws + WS_SS);
    for (int m = gw; m < M; m += NGW) {
        const f32x4* xr = (const f32x4*)(a.in[0] + (size_t)m * D) + lane; float s = 0.f;
        unsigned long long* o8 = (unsigned long long*)(XB + (size_t)m * D) + lane;
#pragma unroll
        for (int j = 0; j < 4; ++j) { const f32x4 v = xr[64 * j]; s += (v[0] * v[0] + v[1] * v[1]) + (v[2] * v[2] + v[3] * v[3]);
            o8[64 * j] = (unsigned long long)cvt_pk_bf16(v[0], v[1]) | ((unsigned long long)cvt_pk_bf16(v[2], v[3]) << 32); }
        s = wave_sum(s);
        if (lane < 4) SS[(size_t)m * 4 + lane] = lane == 0 ? s : 0.f;
    }
    for (int m = gw; m < 2 * BATCH * NMEM; m += NGW) {
        const int l = m / (BATCH * NMEM), rr = m % (BATCH * NMEM);
        const f32x4* xr = (const f32x4*)(a.in[1] + (size_t)rr * D) + lane; const f32x4* gr = (const f32x4*)(a.in[18] + l * D) + lane; f32x4 v[4]; float s = 0.f;
#pragma unroll
        for (int j = 0; j < 4; ++j) { v[j] = xr[64 * j]; s += (v[j][0] * v[j][0] + v[j][1] * v[j][1]) + (v[j][2] * v[j][2] + v[j][3] * v[j][3]); }
        const float rs = 1.0f / sqrtf(wave_sum(s) * (1.0f / D) + 1e-6f);
        unsigned long long* o8 = (unsigned long long*)((bf16_t*)(ws + WS_MEMN) + (size_t)m * D) + lane;
#pragma unroll
        for (int j = 0; j < 4; ++j) { const f32x4 g = gr[64 * j]; const f32x4 y = v[j] * rs * g;
            o8[64 * j] = (unsigned long long)cvt_pk_bf16(y[0], y[1]) | ((unsigned long long)cvt_pk_bf16(y[2], y[3]) << 32); }
    }
}

__device__ __forceinline__ void mixer_a(const bf16_t* Z, bf16_t* Y, const float* sw, int ch, int tid) {
    const int m0 = ch * 128, t0 = m0 & (SEQ - 1);
    const int cp = tid & 127, tg = tid >> 7, c = 2 * cp;
    const float w0a = sw[c], w0b = sw[c + 1], w1a = sw[256 + c], w1b = sw[256 + c + 1], w2a = sw[512 + c], w2b = sw[512 + c + 1];
    const int ms = m0 + 32 * tg, tpos = t0 + 32 * tg;
    float p2a = 0.f, p2b = 0.f, p1a = 0.f, p1b = 0.f;
    if (tpos >= 2) {
        const bf16_t* z2 = Z + (size_t)(ms - 2) * DZ + c; const bf16_t* z1 = Z + (size_t)(ms - 1) * DZ + c;
        unsigned uc = *(const unsigned*)(z2 + 256), ux = *(const unsigned*)(z2 + 512); p2a = bf_lo(uc) * bf_lo(ux); p2b = bf_hi(uc) * bf_hi(ux);
        uc = *(const unsigned*)(z1 + 256); ux = *(const unsigned*)(z1 + 512); p1a = bf_lo(uc) * bf_lo(ux); p1b = bf_hi(uc) * bf_hi(ux);
    }
#pragma unroll 4
    for (int i = 0; i < 32; ++i) {
        const bf16_t* zr = Z + (size_t)(ms + i) * DZ + c;
        const unsigned ub = *(const unsigned*)zr, uc = *(const unsigned*)(zr + 256), ux = *(const unsigned*)(zr + 512);
        const float pa = bf_lo(uc) * bf_lo(ux), pb = bf_hi(uc) * bf_hi(ux);
        const float ya = bf_lo(ub) * (w0a * p2a + w1a * p1a + w2a * pa), yb = bf_hi(ub) * (w0b * p2b + w1b * p1b + w2b * pb);
        *(unsigned*)(Y + (size_t)(ms + i) * D + c) = cvt_pk_bf16(ya, yb);
        p2a = p1a; p2b = p1b; p1a = pa; p1b = pb;
    }
}
__device__ __forceinline__ void mixer_d(const bf16_t* Z, bf16_t* Y, const float* pw, const float* pscale, LAS unsigned char* lds, int ch, int tid) {
    LAS float* PL = (LAS float*)lds;
    const int m0 = ch * 128, t0 = m0 & (SEQ - 1);
    {
        const int cp = tid & 127, tg = tid >> 7, c = 2 * cp, g = c >> 6, k = 2 << g;
        const int ms = m0 + 32 * tg, tpos = t0 + 32 * tg;
        float sa = 0.f, sb = 0.f;
        for (int j = 1; j < k; ++j) if (tpos - j >= 0) { const unsigned u = *(const unsigned*)(Z + (size_t)(ms - j) * DZ + 1792 + c); sa += bf_lo(u); sb += bf_hi(u); }
        for (int i = 0; i < 32; ++i) {
            const unsigned u = *(const unsigned*)(Z + (size_t)(ms + i) * DZ + 1792 + c); const float wa = bf_lo(u), wb = bf_hi(u);
            sa += wa; sb += wb;
            const int cnt = (tpos + i + 1 < k) ? (tpos + i + 1) : k; const float inv = 1.0f / (float)cnt;
            *(LAS f32x2*)(PL + (32 * tg + i) * 256 + c) = (f32x2){sa * inv - wa, sb * inv - wb};
            if (tpos + i - (k - 1) >= 0) { const unsigned u2 = *(const unsigned*)(Z + (size_t)(ms + i - (k - 1)) * DZ + 1792 + c); sa -= bf_lo(u2); sb -= bf_hi(u2); }
        }
    }
    __syncthreads();
    {
        const int dcol = tid & 255, th = tid >> 8, g = dcol >> 6, d = dcol & 63;
        float w[64];
#pragma unroll
        for (int c = 0; c < 64; ++c) w[c] = pw[((size_t)g * 64 + c) * 64 + d];
        const float sc = pscale[dcol];
        for (int tt = 0; tt < 64; ++tt) { const int t = 64 * th + tt; float acc = 0.f;
#pragma unroll
            for (int c4 = 0; c4 < 16; ++c4) { const f32x4 p = *(const LAS f32x4*)(PL + t * 256 + g * 64 + 4 * c4);
                acc += p[0] * w[4 * c4] + p[1] * w[4 * c4 + 1] + p[2] * w[4 * c4 + 2] + p[3] * w[4 * c4 + 3]; }
            const float y = acc * sc; const float yn = __shfl_down(y, 1);
            if (!(tid & 1)) *(unsigned*)(Y + (size_t)(m0 + t) * D + 768 + dcol) = cvt_pk_bf16(y, yn); }
    }
    __syncthreads();
}
__device__ __forceinline__ void mixer_c(const bf16_t* Z, bf16_t* Y, const float* cw, const float* lng, const float* lnb, LAS unsigned char* lds, int hc, int tid) {
    LAS float* GL = (LAS float*)lds;
    const int m0 = hc * 64, t0 = m0 & (SEQ - 1);
    for (int idx = tid; idx < 94 * 128; idx += NTHR) { const int r = idx >> 7, cp = idx & 127; float ga = 0.f, gb = 0.f;
        if (t0 - 30 + r >= 0) { const bf16_t* zr = Z + (size_t)(m0 - 30 + r) * DZ + 2 * cp; const unsigned ua = *(const unsigned*)(zr + 1280), ug = *(const unsigned*)(zr + 1536);
            ga = bf_lo(ua) * __builtin_amdgcn_rcpf(1.0f + __expf(-bf_lo(ug))); gb = bf_hi(ua) * __builtin_amdgcn_rcpf(1.0f + __expf(-bf_hi(ug))); }
        *(LAS f32x2*)(GL + r * 256 + 2 * cp) = (f32x2){ga, gb}; }
    __syncthreads();
    float outv[2][16];
    const int c = tid & 255;
    {
        float w[31];
#pragma unroll
        for (int k = 0; k < 31; ++k) w[k] = cw[k * 256 + c];
#pragma unroll
        for (int it = 0; it < 2; ++it) { const int tg = (tid >> 8) + 2 * it; float gv[46];
#pragma unroll
            for (int j = 0; j < 46; ++j) gv[j] = GL[(16 * tg + j) * 256 + c];
#pragma unroll
            for (int j = 0; j < 16; ++j) { float acc = 0.f;
#pragma unroll
                for (int k = 0; k < 31; ++k) acc += w[k] * gv[j + k];
                outv[it][j] = acc; } }
    }
    __syncthreads();
#pragma unroll
    for (int it = 0; it < 2; ++it) { const int tg = (tid >> 8) + 2 * it;
#pragma unroll
        for (int j = 0; j < 16; ++j) GL[(16 * tg + j) * 256 + c] = outv[it][j]; }
    __syncthreads();
    {
        const int wave = tid >> 6, lane = tid & 63;
        const f32x4 g4 = *(const f32x4*)(lng + 4 * lane), b4 = *(const f32x4*)(lnb + 4 * lane);
#pragma unroll
        for (int i = 0; i < 8; ++i) { const int tt = wave * 8 + i; f32x4 v = *(const LAS f32x4*)(GL + tt * 256 + 4 * lane);
            const float mu = wave_sum((v[0] + v[1]) + (v[2] + v[3])) * (1.0f / 256.0f); v = v - mu;
            const float var = wave_sum((v[0] * v[0] + v[1] * v[1]) + (v[2] * v[2] + v[3] * v[3])) * (1.0f / 256.0f);
            const float rs = 1.0f / sqrtf(var + 1e-6f); f32x4 y = v * rs * g4 + b4;
            y[0] = pg8::fast_silu(y[0]); y[1] = pg8::fast_silu(y[1]); y[2] = pg8::fast_silu(y[2]); y[3] = pg8::fast_silu(y[3]);
            u32x2 o; o.x = cvt_pk_bf16(y[0], y[1]); o.y = cvt_pk_bf16(y[2], y[3]);
            *(u32x2*)(Y + (size_t)(m0 + tt) * D + 512 + 4 * lane) = o; }
    }
    __syncthreads();
}
__device__ __forceinline__ void mixer_b(const bf16_t* Z, bf16_t* Y, const float* ng, const float* wsg, const float* bs, LAS unsigned char* lds, int ch, int tid) {
    constexpr int VS = 136;
    LAS bf16_t* VT = (LAS bf16_t*)lds;
    const int m0 = ch * 128, wave = tid >> 6, lane = tid & 63, fr = lane & 15, fq = lane >> 4;
    {
        const f32x4 g4 = *(const f32x4*)(ng + 4 * lane);
        unsigned pk[4][8];
#pragma unroll
        for (int j2 = 0; j2 < 8; ++j2) { float y[2][4];
#pragma unroll
            for (int e = 0; e < 2; ++e) { const int s = 16 * wave + 2 * j2 + e; const u32x2 u = *(const u32x2*)(Z + (size_t)(m0 + s) * DZ + 1024 + 4 * lane);
                f32x4 v = (f32x4){bf_lo(u.x), bf_hi(u.x), bf_lo(u.y), bf_hi(u.y)};
                const float mu = wave_sum((v[0] + v[1]) + (v[2] + v[3])) * (1.0f / 256.0f); v = v - mu;
                const float var = wave_sum((v[0] * v[0] + v[1] * v[1]) + (v[2] * v[2] + v[3] * v[3])) * (1.0f / 256.0f);
                const float rs = 1.0f / sqrtf(var + 1e-6f); const f32x4 o = v * rs * g4;
                y[e][0] = o[0]; y[e][1] = o[1]; y[e][2] = o[2]; y[e][3] = o[3]; }
#pragma unroll
            for (int i = 0; i < 4; ++i) pk[i][j2] = cvt_pk_bf16(y[0][i], y[1][i]); }
#pragma unroll
        for (int i = 0; i < 4; ++i) { LAS u32x4* dst = (LAS u32x4*)(VT + (4 * lane + i) * VS + 16 * wave);
            dst[0] = (u32x4){pk[i][0], pk[i][1], pk[i][2], pk[i][3]}; dst[1] = (u32x4){pk[i][4], pk[i][5], pk[i][6], pk[i][7]}; }
    }
    __syncthreads();
    {
        const int h = wave >> 1, th = wave & 1;
        f32x4 acc[4][4];
#pragma unroll
        for (int mt = 0; mt < 4; ++mt)
#pragma unroll
            for (int nt = 0; nt < 4; ++nt) acc[mt][nt] = (f32x4){0.f, 0.f, 0.f, 0.f};
#pragma unroll
        for (int ks = 0; ks < 4; ++ks) {
            if (32 * ks > 64 * th + 63) continue;
            bf16x8 bfr[4];
#pragma unroll
            for (int nt = 0; nt < 4; ++nt) bfr[nt] = *(const LAS bf16x8*)(VT + (h * 64 + 16 * nt + fr) * VS + 32 * ks + 8 * fq);
#pragma unroll
            for (int mt = 0; mt < 4; ++mt) { const int t = 64 * th + 16 * mt + fr, s = 32 * ks + 8 * fq;
                const f32x4* wp = (const f32x4*)(wsg + ((size_t)h * 128 + t) * 128 + s); f32x4 w0 = wp[0], w1 = wp[1];
#pragma unroll
                for (int e = 0; e < 4; ++e) { if (s + e > t) w0[e] = 0.f; if (s + 4 + e > t) w1[e] = 0.f; }
                u32x4 au; au.x = cvt_pk_bf16(w0[0], w0[1]); au.y = cvt_pk_bf16(w0[2], w0[3]); au.z = cvt_pk_bf16(w1[0], w1[1]); au.w = cvt_pk_bf16(w1[2], w1[3]);
                const bf16x8 afr = __builtin_bit_cast(bf16x8, au);
#pragma unroll
                for (int nt = 0; nt < 4; ++nt) acc[mt][nt] = __builtin_amdgcn_mfma_f32_16x16x32_bf16(bfr[nt], afr, acc[mt][nt], 0, 0, 0); }
        }
#pragma unroll
        for (int mt = 0; mt < 4; ++mt) { const int t = 64 * th + 16 * mt + fr; const float bias = bs[h * 128 + t];
#pragma unroll
            for (int nt = 0; nt < 4; ++nt) { const int d0 = h * 64 + 16 * nt + 4 * fq; const u32x2 u = *(const u32x2*)(Z + (size_t)(m0 + t) * DZ + 768 + d0);
                const f32x4 a = acc[mt][nt]; u32x2 o; o.x = cvt_pk_bf16(bf_lo(u.x) * (a[0] + bias), bf_hi(u.x) * (a[1] + bias)); o.y = cvt_pk_bf16(bf_lo(u.y) * (a[2] + bias), bf_hi(u.y) * (a[3] + bias));
                *(u32x2*)(Y + (size_t)(m0 + t) * D + 256 + d0) = o; } }
    }
    __syncthreads();
}

__global__ void __launch_bounds__(NTHR, 2) mk_fwd(Args args) {
    extern __shared__ __attribute__((aligned(16))) unsigned char lds_raw[];
    LAS unsigned char* lds = (LAS unsigned char*)lds_raw;
    const int tid = threadIdx.x, lane = tid & 63, wave = __builtin_amdgcn_readfirstlane(tid >> 6);
    const int G = gridDim.x, bx = blockIdx.x;
    const int gw = bx * NWAVES + wave, NGW = G * NWAVES;
    unsigned char* ws = args.ws;
    float* X = args.out;
    bf16_t* XB = (bf16_t*)(ws + WS_XB); float* SS = (float*)(ws + WS_SS);
    bf16_t* ACT = (bf16_t*)(ws + WS_R + R_ACT); bf16_t* Zb = (bf16_t*)(ws + WS_R + R_Z); bf16_t* Yb = (bf16_t*)(ws + WS_R + R_Y);
    bf16_t* Qb = (bf16_t*)(ws + WS_R + R_Q); bf16_t* Pb = (bf16_t*)(ws + WS_R + R_P); bf16_t* Ob = (bf16_t*)(ws + WS_R + R_O);
    const int lo = args.ph_lo, hi = args.ph_hi;
    cg::grid_group grid = cg::this_grid();
    volatile LAS unsigned* bst = (volatile LAS unsigned*)(lds + RING_BYTES + 8192);
    if (tid < 2) bst[tid] = 0u;
    __syncthreads();
    XcdBarrier xbar; xbar.bar = (unsigned*)(ws + WS_CTL); xbar.x = 0; xbar.st = bst;
    if (hi - lo > 1) xbar = xcd_barrier_post((unsigned*)(ws + WS_CTL), bst);
    if (lo < 0) grid.sync();
#define IN(k) (lo <= (k) && (k) < hi)
#define SEAM(k) do { if (IN(k) && IN((k) + 1)) { xcd_barrier(xbar); if (PROBE_MASK & (1 << 10)) xcd_barrier(xbar); } } while (0)
#define REP(cls) for (int rep_ = 0; rep_ < ((PROBE_MASK >> (cls)) & 1) + 1; ++rep_)

    if (IN(0)) REP(0) p0_prologue(args, lds, gw, NGW, wave, lane);
    SEAM(0);
#pragma unroll 1
    for (int l = 0; l < 2; ++l) {
        const int pb = 1 + 11 * l;
        unsigned char* wl = ws + WS_W + (size_t)l * W_LAYER;
        if (IN(pb + 0)) {
            REP(1) { pg8::Gemm g = pg8::plain_gemm(XB, (const bf16_t*)(wl + W_1IN), D); pg8::StaticOrder S; S.init(M, 2 * DFF, G, bx);
              pg8::EpiSwiGLU E{ACT, SS}; pg8::gemm_phase<pg8::EpiSwiGLU, pg8::StaticOrder, true>(lds, g, S, E); }
            if (l == 0) {
                for (int kk = 0; kk < 4; ++kk) { const int ll = kk >> 1, isv = kk & 1; const int c2 = (bx + 2 * G - 128 - 32 * kk) % G;
                    const bf16_t* memn = (const bf16_t*)(ws + WS_MEMN) + (size_t)ll * 1024 * D; const bf16_t* wkv = (const bf16_t*)(ws + WS_W + (size_t)ll * W_LAYER + W_KV);
                    pg8::StaticOrder S; S.init(1024, 1024, G, c2);
                    if (!isv) { pg8::Gemm g = pg8::plain_gemm(memn, wkv, D); pg8::EpiBf16 E{(bf16_t*)(ws + WS_KB) + (size_t)ll * 1024 * 1024, 1024, nullptr, 1.0f};
                        pg8::gemm_phase<pg8::EpiBf16, pg8::StaticOrder, true>(lds, g, S, E); }
                    else { pg8::Gemm g = pg8::plain_gemm(wkv + (size_t)1024 * D, memn, D); pg8::EpiBf16 E{(bf16_t*)(ws + WS_VT) + (size_t)ll * 1024 * 1024, 1024, nullptr, 1.0f};
                        pg8::gemm_phase<pg8::EpiBf16, pg8::StaticOrder, true>(lds, g, S, E); } }
            }
        }
        SEAM(pb + 0);
        if (IN(pb + 1)) REP(2) { pg8::Gemm g = pg8::plain_gemm(ACT, (const bf16_t*)(wl + W_1OUT), DFF); pg8::StaticOrder S; S.init(M, D, G, bx);
            pg8::EpiResid E{(l == 0 && rep_ == 0) ? args.in[0] : X, X, XB, SS, rep_ == 0 ? 0.5f : 0.f}; pg8::gemm_phase<pg8::EpiResid, pg8::StaticOrder, true>(lds, g, S, E); }
        SEAM(pb + 1);
        if (IN(pb + 2)) REP(3) { pg8::Gemm g = pg8::plain_gemm(XB, (const bf16_t*)(wl + W_MIXIN), D); pg8::StaticOrder S; S.init(M, DZ, G, bx);
            pg8::EpiBf16 E{Zb, DZ, SS, 1.0f}; pg8::gemm_phase<pg8::EpiBf16, pg8::StaticOrder, true>(lds, g, S, E); }
        SEAM(pb + 2);
        if (IN(pb + 3)) REP(4) {
            for (int u = bx; u < 640; u += G) {
                int ptid = tid; asm volatile("" : "+v"(ptid));
                if (u < 256) mixer_c(Zb, Yb, args.in[11] + l * 31 * 256, args.in[12] + l * 256, args.in[13] + l * 256, lds, u, ptid);
                else if (u < 384) mixer_b(Zb, Yb, args.in[8] + l * 256, args.in[9] + (size_t)l * 4 * 128 * 128, args.in[10] + l * 4 * 128, lds, u - 256, ptid);
                else if (u < 512) mixer_d(Zb, Yb, args.in[14] + (size_t)l * 4 * 64 * 64, args.in[15] + l * 256, lds, u - 384, ptid);
                else mixer_a(Zb, Yb, args.in[7] + l * 3 * 256, u - 512, ptid);
            }
        }
        SEAM(pb + 3);
        if (IN(pb + 4)) REP(5) { pg8::Gemm g = pg8::plain_gemm(Yb, (const bf16_t*)(wl + W_MIXOUT), D); pg8::StaticOrder S; S.init(M, D, G, bx);
            pg8::EpiResid E{X, X, XB, SS, rep_ == 0 ? 1.0f : 0.f}; pg8::gemm_phase<pg8::EpiResid, pg8::StaticOrder, true>(lds, g, S, E); }
        SEAM(pb + 4);
        if (IN(pb + 5)) REP(6) { pg8::Gemm g = pg8::plain_gemm(XB, (const bf16_t*)(wl + W_Q), D); pg8::StaticOrder S; S.init(M, D, G, bx);
            pg8::EpiBf16 E{Qb, D, SS, QSCALE}; pg8::gemm_phase<pg8::EpiBf16, pg8::StaticOrder, true>(lds, g, S, E); }
        SEAM(pb + 5);
        if (IN(pb + 6)) REP(7) { pg8::Gemm g; g.A = Qb; g.Bt = (const bf16_t*)(ws + WS_KB) + (size_t)l * 1024 * 1024; g.lda = 1024; g.ldb = 1024; g.K = 256;
            g.a_pm = 256L * 1024; g.a_pn = 256; g.b_pn = 256; g.b_pb = 256L * 1024;
            pg8::StaticOrder S; S.init(M, D, G, bx); pg8::EpiSoftmax E{Pb}; pg8::gemm_phase<pg8::EpiSoftmax, pg8::StaticOrder, false>(lds, g, S, E); }
        SEAM(pb + 6);
        if (IN(pb + 7)) REP(8) { pg8::Gemm g; g.A = Pb; g.Bt = (const bf16_t*)(ws + WS_VT) + (size_t)l * 1024 * 1024; g.lda = 1024; g.ldb = 1024; g.K = 256;
            g.a_pm = 256L * 1024; g.a_pn = 256; g.b_pn = 256L * 1024; g.b_pb = 256;
            pg8::StaticOrder S; S.init(M, D, G, bx); pg8::EpiBf16 E{Ob, D, nullptr, 1.0f}; pg8::gemm_phase<pg8::EpiBf16, pg8::StaticOrder, true>(lds, g, S, E); }
        SEAM(pb + 7);
        if (IN(pb + 8)) REP(9) { pg8::Gemm g = pg8::plain_gemm(Ob, (const bf16_t*)(wl + W_O), D); pg8::StaticOrder S; S.init(M, D, G, bx);
            pg8::EpiResid E{X, X, XB, SS, rep_ == 0 ? 1.0f : 0.f}; pg8::gemm_phase<pg8::EpiResid, pg8::StaticOrder, true>(lds, g, S, E); }
        SEAM(pb + 8);
        if (IN(pb + 9)) REP(1) { pg8::Gemm g = pg8::plain_gemm(XB, (const bf16_t*)(wl + W_2IN), D); pg8::StaticOrder S; S.init(M, 2 * DFF, G, bx);
            pg8::EpiSwiGLU E{ACT, SS}; pg8::gemm_phase<pg8::EpiSwiGLU, pg8::StaticOrder, true>(lds, g, S, E); }
        SEAM(pb + 9);
        if (IN(pb + 10)) REP(2) { pg8::Gemm g = pg8::plain_gemm(ACT, (const bf16_t*)(wl + W_2OUT), DFF); pg8::StaticOrder S; S.init(M, D, G, bx);
            pg8::EpiResid E{X, X, XB, SS, rep_ == 0 ? 0.5f : 0.f}; pg8::gemm_phase<pg8::EpiResid, pg8::StaticOrder, true>(lds, g, S, E); }
        SEAM(pb + 10);
    }
    if (IN(23)) {
        const f32x4* gf = (const f32x4*)args.in[25] + lane;
        for (int m = gw; m < M; m += NGW) { const float rs = pg8::row_rs(SS, m); f32x4* xr = (f32x4*)(X + (size_t)m * D) + lane;
#pragma unroll
            for (int j = 0; j < 4; ++j) xr[64 * j] = xr[64 * j] * rs * gf[64 * j]; }
    }
#undef IN
#undef SEAM
#undef REP
}
}
#define MK_MODE 0

#ifndef MK_MODE
#define MK_MODE 0
#endif
extern "C" void kernel_launch(void* const* d_in, const int* in_sizes, int n_in, void* d_out, int out_size, void* d_ws, size_t ws_size, hipStream_t stream) {
    using namespace mk;
    static int grid = 0;
    if (grid == 0) {
        if (n_in != 26 || out_size != M * D || ws_size < WS_END) { fprintf(stderr, "kernel_launch: unexpected shapes (n_in %d out %d ws %zu)\n", n_in, out_size, ws_size); grid = -1; return; }
        int dev = 0, cus = 0, per_cu = 0;
        hipGetDevice(&dev); hipDeviceGetAttribute(&cus, hipDeviceAttributeMultiprocessorCount, dev);
        if (hipFuncSetAttribute((const void*)mk_fwd, hipFuncAttributeMaxDynamicSharedMemorySize, LDS_BYTES) != hipSuccess) { fprintf(stderr, "kernel_launch: hipFuncSetAttribute failed\n"); grid = -1; return; }
        if (hipOccupancyMaxActiveBlocksPerMultiprocessor(&per_cu, (const void*)mk_fwd, NTHR, LDS_BYTES) != hipSuccess || per_cu < 1) { fprintf(stderr, "kernel_launch: occupancy query failed (%d)\n", per_cu); per_cu = 1; }
        (void)hipGetLastError();
        grid = cus * per_cu;
        fprintf(stderr, "kernel_launch: cus %d per_cu %d grid %d\n", cus, per_cu, grid);
    }
    if (grid < 0) return;
    Args a{};
    for (int i = 0; i < 26; ++i) a.in[i] = (const float*)d_in[i];
    a.out = (float*)d_out; a.ws = (unsigned char*)d_ws;
#if MK_MODE == 0
    a.ph_lo = 0; a.ph_hi = NPH;
    if (hipMemsetAsync((char*)d_ws + WS_CTL, 0, 16384, stream) != hipSuccess) { fprintf(stderr, "kernel_launch: memset of the barrier words failed\n"); return; }
    void* kargs[] = {&a};
    hipError_t e = hipLaunchCooperativeKernel((const void*)mk_fwd, dim3(grid), dim3(NTHR), kargs, LDS_BYTES, stream);
    if (e != hipSuccess) fprintf(stderr, "kernel_launch: cooperative launch failed: %s (grid %d)\n", hipGetErrorString(e), grid);
#else
    for (int p = 0; p < NPH; ++p) { a.ph_lo = p; a.ph_hi = p + 1; hipLaunchKernelGGL(mk_fwd, dim3(grid), dim3(NTHR), LDS_BYTES, stream, a); }
#endif
}
```

```cpp
#include <hip/hip_runtime.h>
#include <hip/hip_cooperative_groups.h>
#include <cstdio>
#include <cstdint>
namespace cg = cooperative_groups;
namespace pg8 {
#define PG8_LAS __attribute__((address_space(3)))
typedef unsigned short bf16_t;
typedef short bf16x8 __attribute__((ext_vector_type(8)));
typedef float f32x4 __attribute__((ext_vector_type(4)));
typedef float f32x2 __attribute__((ext_vector_type(2)));
typedef unsigned u32x4 __attribute__((ext_vector_type(4)));
typedef unsigned u32x2 __attribute__((ext_vector_type(2)));
constexpr int BM = 256, BK = 64, HALF = 128, HTB = HALF * BK * 2, STAGE_BYTES = 8 * HTB, NXCD = 8, WGM = 8;

__host__ __device__ __forceinline__ int lds_byte(int r, int c) { const int st = (r >> 4) * 2 + (c >> 5), rr = r & 15, cc = c & 31, ob = rr * 64 + cc * 2; return st * 1024 + (ob ^ (((ob >> 9) & 1) << 5)); }
__host__ __device__ __forceinline__ void stage_rc(int b, int& R, int& C) { const int st = b / 1024, sb = b % 1024, swz = sb ^ (((sb >> 9) & 1) << 5); R = (st >> 1) * 16 + swz / 64; C = (st & 1) * 32 + (swz % 64) / 2; }
__host__ __device__ __forceinline__ int perm32(int rho) { const int n = rho >> 4, i = rho & 15; return 8 * (i >> 2) + 4 * n + (i & 3); }

struct Unit { int pm, pn; };
struct Gemm { const bf16_t* A; const bf16_t* Bt; int lda, ldb, K; long a_pm, a_pn, b_pn, b_pb; };
__device__ __forceinline__ Gemm plain_gemm(const bf16_t* A, const bf16_t* Bt, int K) { Gemm g; g.A = A; g.Bt = Bt; g.lda = K; g.ldb = K; g.K = K; g.a_pm = 256L * K; g.a_pn = 0; g.b_pn = 256L * K; g.b_pb = 0; return g; }

struct StaticOrder {
    int nM, nN, nwg, G, c;
    __host__ __device__ void init(int M, int N, int G_, int c_) { nM = M / BM; nN = N / BM; nwg = nM * nN; G = G_; c = c_; }
    __host__ __device__ bool next(int i, Unit& u) const {
        const long L = (long)i * G + c; if (L >= nwg) return false;
        int wgid = (int)L; { const int q = nwg / NXCD, r = nwg % NXCD, xcd = wgid % NXCD, off = wgid / NXCD; wgid = (xcd < r ? xcd * (q + 1) : r * (q + 1) + (xcd - r) * q) + off; }
        const int nig = WGM * nN, gid = wgid / nig, fm = gid * WGM, gsz = (nM - fm) < WGM ? (nM - fm) : WGM;
        u.pm = fm + ((wgid % nig) % gsz); u.pn = (wgid % nig) / gsz; return true;
    }
};

__device__ __forceinline__ unsigned cvt_pk_bf16(float lo, float hi) { unsigned r; asm volatile("v_cvt_pk_bf16_f32 %0, %1, %2" : "=v"(r) : "v"(lo), "v"(hi)); return r; }

__device__ __forceinline__ float row_rs(const float* ss, int row) {
    const f32x4 a = *(const f32x4*)(ss + (size_t)row * 4);
    const float s = (a[0] + a[1]) + (a[2] + a[3]);
    return 1.0f / sqrtf(s * (1.0f / 1024.0f) + 1e-6f);
}
__device__ __forceinline__ float fast_silu(float g) { return g * __builtin_amdgcn_rcpf(1.0f + __expf(-g)); }


struct EpiBf16 {
    static constexpr bool PERM = true, AFTER_DRAIN = false;
    bf16_t* O; int ldc; const float* ss; float scale;
    __device__ __forceinline__ void operator()(const f32x4 (&acc)[2][2][4][2], const Unit& u, int wr, int wc, int fr, int fq, PG8_LAS unsigned char* spare, int tid) const {
        const int row0 = u.pm * BM + wr * 64 + fr, col0 = u.pn * BM + wc * 32 + 8 * fq;
#pragma unroll
        for (int ai = 0; ai < 2; ++ai)
#pragma unroll
            for (int m = 0; m < 4; ++m) { const int row = row0 + ai * HALF + m * 16; const float sc = ss ? row_rs(ss, row) * scale : scale;
                bf16_t* rowp = O + (size_t)row * ldc + col0;
#pragma unroll
                for (int bj = 0; bj < 2; ++bj) { const f32x4 v0 = acc[ai][bj][m][0] * sc, v1 = acc[ai][bj][m][1] * sc;
                    u32x4 w; w.x = cvt_pk_bf16(v0[0], v0[1]); w.y = cvt_pk_bf16(v0[2], v0[3]); w.z = cvt_pk_bf16(v1[0], v1[1]); w.w = cvt_pk_bf16(v1[2], v1[3]);
                    *(u32x4*)(rowp + bj * HALF) = w; } }
    }
};
struct EpiSwiGLU {
    static constexpr bool PERM = true, AFTER_DRAIN = false;
    bf16_t* O; const float* ss;
    __device__ __forceinline__ void operator()(const f32x4 (&acc)[2][2][4][2], const Unit& u, int wr, int wc, int fr, int fq, PG8_LAS unsigned char* spare, int tid) const {
        const int row0 = u.pm * BM + wr * 64 + fr, col0 = u.pn * HALF + wc * 32 + 8 * fq;
#pragma unroll
        for (int ai = 0; ai < 2; ++ai)
#pragma unroll
            for (int m = 0; m < 4; ++m) { const int row = row0 + ai * HALF + m * 16; const float sc = row_rs(ss, row);
                const f32x4 g0 = acc[ai][0][m][0] * sc, g1 = acc[ai][0][m][1] * sc, u0 = acc[ai][1][m][0] * sc, u1 = acc[ai][1][m][1] * sc;
                u32x4 w; w.x = cvt_pk_bf16(fast_silu(g0[0]) * u0[0], fast_silu(g0[1]) * u0[1]); w.y = cvt_pk_bf16(fast_silu(g0[2]) * u0[2], fast_silu(g0[3]) * u0[3]);
                w.z = cvt_pk_bf16(fast_silu(g1[0]) * u1[0], fast_silu(g1[1]) * u1[1]); w.w = cvt_pk_bf16(fast_silu(g1[2]) * u1[2], fast_silu(g1[3]) * u1[3]);
                *(u32x4*)(O + (size_t)row * 2816 + col0) = w; }
    }
};
struct EpiResid {
    static constexpr bool PERM = false, AFTER_DRAIN = false;
    const float* base; float* out; bf16_t* xb; float* ss; float alpha;
    __device__ __forceinline__ void operator()(const f32x4 (&acc)[2][2][4][2], const Unit& u, int wr, int wc, int fr, int fq, PG8_LAS unsigned char* spare, int tid) const {
        PG8_LAS float* Pq = (PG8_LAS float*)spare;
        const int row0 = u.pm * BM + wr * 64 + fr, col0 = u.pn * BM + wc * 32 + 4 * fq;
#pragma unroll
        for (int ai = 0; ai < 2; ++ai)
#pragma unroll
            for (int m = 0; m < 4; ++m) { const int row = row0 + ai * HALF + m * 16; const size_t off = (size_t)row * 1024 + col0; float q = 0.f;
#pragma unroll
                for (int bj = 0; bj < 2; ++bj)
#pragma unroll
                    for (int n = 0; n < 2; ++n) { const f32x4 b = *(const f32x4*)(base + off + bj * HALF + n * 16); const f32x4 o = b + acc[ai][bj][m][n] * alpha;
                        *(f32x4*)(out + off + bj * HALF + n * 16) = o; u32x2 w; w.x = cvt_pk_bf16(o[0], o[1]); w.y = cvt_pk_bf16(o[2], o[3]);
                        *(u32x2*)(xb + off + bj * HALF + n * 16) = w; q += (o[0] * o[0] + o[1] * o[1]) + (o[2] * o[2] + o[3] * o[3]); }
                q += __shfl_xor(q, 16); q += __shfl_xor(q, 32);
                if (fq == 0) Pq[(ai * HALF + wr * 64 + m * 16 + fr) * 4 + wc] = q;
                if (m & 1) asm volatile("" ::: "memory"); }
        asm volatile("s_waitcnt lgkmcnt(0)" ::: "memory"); __builtin_amdgcn_s_barrier(); asm volatile("" ::: "memory");
        if (tid < 256) { const f32x4 v = *(const PG8_LAS f32x4*)(Pq + tid * 4); ss[(size_t)(u.pm * BM + tid) * 4 + u.pn] = (v[0] + v[1]) + (v[2] + v[3]); }
    }
};
struct EpiSoftmax {
    static constexpr bool PERM = true, AFTER_DRAIN = true;
    bf16_t* P;
    __device__ __forceinline__ void fused(f32x4 (&acc)[2][2][4][2], const Unit& u, int wr, int wc, int fr, int fq, PG8_LAS unsigned char* lds, int wid, int lane) const {
        PG8_LAS float* Pm = (PG8_LAS float*)lds;
        PG8_LAS float* Ps = (PG8_LAS float*)(lds + 4096);
#pragma unroll
        for (int ai = 0; ai < 2; ++ai)
#pragma unroll
            for (int m = 0; m < 4; ++m) { float mx = -3.0e38f;
#pragma unroll
                for (int bj = 0; bj < 2; ++bj)
#pragma unroll
                    for (int n = 0; n < 2; ++n) { const f32x4 x = acc[ai][bj][m][n]; mx = fmaxf(mx, fmaxf(fmaxf(x[0], x[1]), fmaxf(x[2], x[3]))); }
                mx = fmaxf(mx, __shfl_xor(mx, 16)); mx = fmaxf(mx, __shfl_xor(mx, 32));
                if (fq == 0) Pm[(ai * HALF + wr * 64 + m * 16 + fr) * 4 + wc] = mx; }
        asm volatile("s_waitcnt lgkmcnt(0)" ::: "memory"); __builtin_amdgcn_s_barrier(); asm volatile("" ::: "memory");
#pragma unroll
        for (int ai = 0; ai < 2; ++ai)
#pragma unroll
            for (int m = 0; m < 4; ++m) { const int r = ai * HALF + wr * 64 + m * 16 + fr; const f32x4 pm4 = *(const PG8_LAS f32x4*)(Pm + r * 4);
                const float mx = fmaxf(fmaxf(pm4[0], pm4[1]), fmaxf(pm4[2], pm4[3])); float s = 0.f;
#pragma unroll
                for (int bj = 0; bj < 2; ++bj)
#pragma unroll
                    for (int n = 0; n < 2; ++n) { f32x4 x = acc[ai][bj][m][n];
                        x[0] = __builtin_amdgcn_exp2f(x[0] - mx); x[1] = __builtin_amdgcn_exp2f(x[1] - mx); x[2] = __builtin_amdgcn_exp2f(x[2] - mx); x[3] = __builtin_amdgcn_exp2f(x[3] - mx);
                        acc[ai][bj][m][n] = x; s += (x[0] + x[1]) + (x[2] + x[3]); }
                s += __shfl_xor(s, 16); s += __shfl_xor(s, 32);
                if (fq == 0) Ps[r * 4 + wc] = s; }
        asm volatile("s_waitcnt lgkmcnt(0)" ::: "memory"); __builtin_amdgcn_s_barrier(); asm volatile("" ::: "memory");
        const int col0 = u.pn * BM + wc * 32 + 8 * fq;
#pragma unroll
        for (int ai = 0; ai < 2; ++ai)
#pragma unroll
            for (int m = 0; m < 4; ++m) { const int r = ai * HALF + wr * 64 + m * 16 + fr; const f32x4 ps4 = *(const PG8_LAS f32x4*)(Ps + r * 4);
                const float inv = 1.0f / ((ps4[0] + ps4[1]) + (ps4[2] + ps4[3]));
                bf16_t* rowp = P + (size_t)(u.pm * BM + r) * 1024 + col0;
#pragma unroll
                for (int bj = 0; bj < 2; ++bj) { const f32x4 v0 = acc[ai][bj][m][0] * inv, v1 = acc[ai][bj][m][1] * inv;
                    u32x4 w; w.x = cvt_pk_bf16(v0[0], v0[1]); w.y = cvt_pk_bf16(v0[2], v0[3]); w.z = cvt_pk_bf16(v1[0], v1[1]); w.w = cvt_pk_bf16(v1[2], v1[3]);
                    *(u32x4*)(rowp + bj * HALF) = w; } }
        asm volatile("s_waitcnt lgkmcnt(0)" ::: "memory"); __builtin_amdgcn_s_barrier(); asm volatile("" ::: "memory");
    }
};

template <class Epi, class Sched, bool ALIGN_EPI>
__device__ __forceinline__ void gemm_phase(PG8_LAS unsigned char* lds, const Gemm g, const Sched& S, const Epi& E) {
    int tid_ = threadIdx.x; asm volatile("" : "+v"(tid_));
    const int tid = tid_, wid = __builtin_amdgcn_readfirstlane(tid >> 6), lane = tid & 63, wr = wid >> 2, wc = wid & 3, fr = lane & 15, fq = lane >> 4;
    const int K = g.K, nt = K / BK;
    unsigned voffA[2], voffB[2];
#pragma unroll
    for (int i = 0; i < 2; ++i) { int R, C; stage_rc(tid * 16 + i * 8192, R, C); const int Rb = Epi::PERM ? ((R & ~31) + perm32(R & 31)) : R;
        voffA[i] = (unsigned)(R * g.lda + C) * 2u; voffB[i] = (unsigned)(Rb * g.ldb + C) * 2u; }
    const size_t kstep = (size_t)(BK * 2);
    const size_t hstepA = (size_t)HALF * g.lda * 2, hstepB = (size_t)HALF * g.ldb * 2;
    const unsigned ldsw = (unsigned)wid * 1024u;
    const int aoff = lds_byte(wr * 64 + fr, fq * 8), boff = lds_byte(wc * 32 + fr, fq * 8);
#define PG8_SA(b, h) (((b) * 2 + (h)) * HTB)
#define PG8_SB(b, h) ((4 + (b) * 2 + (h)) * HTB)
#define PG8_STAGE(bufoff, gbase, voff) do { _Pragma("unroll") for (int _i = 0; _i < 2; ++_i) \
        __builtin_amdgcn_global_load_lds((const unsigned*)((const char*)(gbase) + (voff)[_i]), (PG8_LAS unsigned*)(lds + (bufoff) + ldsw + _i * 8192), 16, 0, 0); } while (0)
#define PG8_LDA(dst, b, h) do { _Pragma("unroll") for (int m = 0; m < 4; ++m) _Pragma("unroll") for (int k = 0; k < 2; ++k) dst[m][k] = *(const PG8_LAS bf16x8*)(lds + PG8_SA(b, h) + aoff + m * 2048 + k * 1024); } while (0)
#define PG8_LDB(dst, b, h) do { _Pragma("unroll") for (int n = 0; n < 2; ++n) _Pragma("unroll") for (int k = 0; k < 2; ++k) dst[n][k] = *(const PG8_LAS bf16x8*)(lds + PG8_SB(b, h) + boff + n * 2048 + k * 1024); } while (0)
#define PG8_MMA(ai, bj, At, Bt) do { __builtin_amdgcn_s_setprio(1); _Pragma("unroll") for (int m = 0; m < 4; ++m) _Pragma("unroll") for (int n = 0; n < 2; ++n) _Pragma("unroll") for (int k = 0; k < 2; ++k) \
        acc[ai][bj][m][n] = __builtin_amdgcn_mfma_f32_16x16x32_bf16(Bt[n][k], At[m][k], acc[ai][bj][m][n], 0, 0, 0); __builtin_amdgcn_s_setprio(0); } while (0)
#define PG8_WAIT_V(n) asm volatile("s_waitcnt vmcnt(" #n ")" ::: "memory")
#define PG8_WAIT_L(n) asm volatile("s_waitcnt lgkmcnt(" #n ")" ::: "memory")
#define PG8_BAR __builtin_amdgcn_s_barrier()
#define PG8_SCHED __builtin_amdgcn_sched_barrier(0)
#define PG8_APTR(u) ((const char*)g.A + ((size_t)(u).pm * g.a_pm + (size_t)(u).pn * g.a_pn) * 2)
#define PG8_BPTR(u) ((const char*)g.Bt + ((size_t)(u).pn * g.b_pn + (size_t)((u).pm >> 4) * g.b_pb) * 2)
    Unit cur, nxt; int ui = 0;
    if (!S.next(0, cur)) return;
    f32x4 acc[2][2][4][2];
#pragma unroll
    for (int a = 0; a < 2; ++a)
#pragma unroll
        for (int b = 0; b < 2; ++b)
#pragma unroll
            for (int m = 0; m < 4; ++m)
#pragma unroll
                for (int n = 0; n < 2; ++n) acc[a][b][m][n] = (f32x4){0.f, 0.f, 0.f, 0.f};
    bf16x8 At[4][2], B0[2][2], B1[2][2];
    const char* cA = PG8_APTR(cur); const char* cB = PG8_BPTR(cur);
    PG8_STAGE(PG8_SB(0, 0), cB, voffB); PG8_STAGE(PG8_SB(0, 1), cB + hstepB, voffB); PG8_STAGE(PG8_SA(0, 0), cA, voffA); PG8_STAGE(PG8_SA(0, 1), cA + hstepA, voffA);
    if (wr == 1) PG8_BAR;
    PG8_WAIT_V(2); PG8_BAR;
    PG8_STAGE(PG8_SB(1, 0), cB + kstep, voffB); PG8_STAGE(PG8_SA(1, 0), cA + kstep, voffA); PG8_STAGE(PG8_SB(1, 1), cB + hstepB + kstep, voffB);
    PG8_WAIT_V(6); PG8_BAR;
    for (;;) {
        const bool has_next = S.next(ui + 1, nxt);
        const char* nA = has_next ? PG8_APTR(nxt) : cA; const char* nB = has_next ? PG8_BPTR(nxt) : cB;
        for (int t = 0; t < nt; t += 2) {
            const bool last = (t == nt - 2);
            const char* a1 = cA + (size_t)(t + 1) * kstep;
            const char* a2 = last ? nA : cA + (size_t)(t + 2) * kstep; const char* b2 = last ? nB : cB + (size_t)(t + 2) * kstep;
            const char* a3 = a2 + kstep; const char* b3 = b2 + kstep;
            PG8_LDB(B0, 0, 0); PG8_LDB(B1, 0, 1); PG8_SCHED; PG8_LDA(At, 0, 0); PG8_STAGE(PG8_SA(1, 1), a1 + hstepA, voffA);
            PG8_WAIT_V(8); PG8_WAIT_L(0); PG8_BAR; PG8_MMA(0, 0, At, B0); PG8_MMA(0, 1, At, B1); PG8_BAR; PG8_SCHED;
            PG8_LDA(At, 0, 1); PG8_STAGE(PG8_SB(0, 0), b2, voffB); PG8_STAGE(PG8_SB(0, 1), b2 + hstepB, voffB); PG8_STAGE(PG8_SA(0, 0), a2, voffA);
            PG8_WAIT_V(8); PG8_WAIT_L(0); PG8_BAR; PG8_MMA(1, 0, At, B0); PG8_MMA(1, 1, At, B1); PG8_BAR; PG8_SCHED;
            PG8_LDB(B0, 1, 0); PG8_LDB(B1, 1, 1); PG8_SCHED; PG8_LDA(At, 1, 0); PG8_STAGE(PG8_SA(0, 1), a2 + hstepA, voffA);
            PG8_WAIT_V(8); PG8_WAIT_L(0); PG8_BAR; PG8_MMA(0, 0, At, B0); PG8_MMA(0, 1, At, B1); PG8_BAR; PG8_SCHED;
            PG8_LDA(At, 1, 1); PG8_STAGE(PG8_SB(1, 0), b3, voffB); PG8_STAGE(PG8_SB(1, 1), b3 + hstepB, voffB); PG8_STAGE(PG8_SA(1, 0), a3, voffA);
            PG8_WAIT_V(8); PG8_WAIT_L(0); PG8_BAR; PG8_MMA(1, 0, At, B0); PG8_MMA(1, 1, At, B1); PG8_BAR; PG8_SCHED;
        }
        if constexpr (ALIGN_EPI) { if (wr == 0) PG8_BAR; }
        if constexpr (!Epi::AFTER_DRAIN) { E(acc, cur, wr, wc, fr, fq, lds + STAGE_BYTES, tid); }
        if (!has_next) break;
#pragma unroll
        for (int a = 0; a < 2; ++a)
#pragma unroll
            for (int b = 0; b < 2; ++b)
#pragma unroll
                for (int m = 0; m < 4; ++m)
#pragma unroll
                    for (int n = 0; n < 2; ++n) acc[a][b][m][n] = (f32x4){0.f, 0.f, 0.f, 0.f};
        cur = nxt; cA = nA; cB = nB; ++ui;
        if constexpr (ALIGN_EPI) { if (wr == 1) PG8_BAR; }
    }
    PG8_WAIT_V(0);
    if constexpr (!ALIGN_EPI) { if (wr == 0) PG8_BAR; }
    PG8_BAR;
    if constexpr (Epi::AFTER_DRAIN) { E.fused(acc, cur, wr, wc, fr, fq, lds, wid, lane); }
#undef PG8_SA
#undef PG8_SB
#undef PG8_STAGE
#undef PG8_LDA
#undef PG8_LDB
#undef PG8_MMA
#undef PG8_WAIT_V
#undef PG8_WAIT_L
#undef PG8_BAR
#undef PG8_SCHED
#undef PG8_APTR
#undef PG8_BPTR
}
}

#ifndef PROBE_MASK
#define PROBE_MASK 0
#endif
namespace mk {
using pg8::bf16_t; using pg8::bf16x8; using pg8::f32x4; using pg8::f32x2; using pg8::u32x4; using pg8::u32x2; using pg8::cvt_pk_bf16;
#define LAS __attribute__((address_space(3)))
constexpr int NWAVES = 8, NTHR = 512;
constexpr int D = 1024, BATCH = 4, SEQ = 4096, M = BATCH * SEQ, DFF = 2816, DZ = 2048, NMEM = 256;
constexpr int LDS_BYTES = 147456, RING_BYTES = 131072;
constexpr size_t MiB = 1u << 20;
constexpr size_t WS_CTL = 0, WS_SS = 1 * MiB, WS_MEMN = 2 * MiB, WS_KB = 6 * MiB, WS_VT = 10 * MiB, WS_W = 14 * MiB, WS_XB = 108 * MiB, WS_R = 140 * MiB, WS_END = 236 * MiB;
constexpr size_t W_LAYER = 47 * MiB;
constexpr size_t W_1IN = 0, W_1OUT = 11 * MiB, W_MIXIN = 16 * MiB + MiB / 2, W_MIXOUT = 20 * MiB + MiB / 2, W_Q = 22 * MiB + MiB / 2, W_KV = 24 * MiB + MiB / 2, W_O = 28 * MiB + MiB / 2,
                 W_2IN = 30 * MiB + MiB / 2, W_2OUT = 41 * MiB + MiB / 2;
constexpr size_t R_ACT = 0, R_Z = 0, R_Y = 64 * MiB, R_Q = 0, R_P = 32 * MiB, R_O = 64 * MiB;
constexpr int NPH = 24;
constexpr float QSCALE = 1.4426950408889634f / 16.0f;

struct Args { const float* in[26]; float* out; unsigned char* ws; int ph_lo, ph_hi; };

__device__ __forceinline__ float wave_sum(float v) {
#pragma unroll
    for (int o = 1; o < 64; o <<= 1) v += __shfl_xor(v, o);
    return v;
}
__device__ __forceinline__ float bf_lo(unsigned u) { return __uint_as_float(u << 16); }
__device__ __forceinline__ float bf_hi(unsigned u) { return __uint_as_float(u & 0xffff0000u); }
#define LDS_WAIT() asm volatile("s_waitcnt lgkmcnt(0)" ::: "memory")


#define XB_TMO      128
#define XB_XCNT(j)  (256  + 64 * (j))
#define XB_XSUB(j)  (1280 + 64 * (j))
#define XB_XGEN(j)  (2304 + 64 * (j))
#define XB_TOP      3328
#define XB_TOPGEN   3392
#define XCD_BAR_WORDS 3456
#define XB_SPIN_CAP (1u << 20)
__device__ __forceinline__ unsigned xb_ld(unsigned* p)              { return __hip_atomic_load(p, __ATOMIC_RELAXED, __HIP_MEMORY_SCOPE_AGENT); }
__device__ __forceinline__ unsigned xb_add(unsigned* p, unsigned v) { return __hip_atomic_fetch_add(p, v, __ATOMIC_RELAXED, __HIP_MEMORY_SCOPE_AGENT); }
__device__ __forceinline__ unsigned xb_xcc_id() { return (unsigned)__builtin_amdgcn_s_getreg((3 << 11) | 20) & 0xFu; }
#define XB_SPIN(cond, bar) do { unsigned _sp = 0; while (cond) { __builtin_amdgcn_s_sleep(1); \
    if ((++_sp & 255u) == 0u) { if (xb_ld(&(bar)[XB_TMO])) break; if (_sp > XB_SPIN_CAP) { atomicAdd(&(bar)[XB_TMO], 1u); break; } } } } while (0)
struct XcdBarrier { unsigned* bar; unsigned x; volatile LAS unsigned* st; };
__device__ __forceinline__ XcdBarrier xcd_barrier_post(unsigned* bar, volatile LAS unsigned* st) {
    XcdBarrier b; b.bar = bar; b.x = xb_xcc_id(); b.st = st;
    if (threadIdx.x == 0) (void)xb_add(&bar[XB_XCNT(b.x)], 1u);
    return b;
}
__device__ __forceinline__ void xcd_barrier_complete(unsigned* bar, unsigned x, unsigned& nloc, unsigned& nx) {
    const unsigned G = gridDim.x * gridDim.y * gridDim.z;
    unsigned sum, cnt, mine, sp = 0u;
    for (;;) {
        sum = 0u; cnt = 0u; mine = 0u;
#pragma unroll
        for (unsigned j = 0; j < 16; ++j) { const unsigned c = xb_ld(&bar[XB_XCNT(j)]); sum += c; cnt += (c > 0u) ? 1u : 0u; mine = (j == x) ? c : mine; }
        if (sum == G) break;
        __builtin_amdgcn_s_sleep(1);
        if ((++sp & 255u) == 0u) { if (xb_ld(&bar[XB_TMO])) break; if (sp > XB_SPIN_CAP) { atomicAdd(&bar[XB_TMO], 1u); break; } }
    }
    nloc = mine > 0u ? mine : 1u; nx = cnt > 0u ? cnt : 1u;
}
__device__ __forceinline__ void xcd_barrier(const XcdBarrier& b) {
    asm volatile("s_waitcnt vmcnt(0)" ::: "memory");
    __syncthreads();
    if (threadIdx.x == 0) {
        unsigned* bar = b.bar;
        __builtin_amdgcn_s_waitcnt(0);
        unsigned nloc = b.st[0], nx = b.st[1];
        if (nloc == 0u) { xcd_barrier_complete(bar, b.x, nloc, nx); b.st[0] = nloc; b.st[1] = nx; }
        const unsigned old = xb_add(&bar[XB_XSUB(b.x)], 1u);
        const unsigned gen = old / nloc;
        if (old + 1u == (gen + 1u) * nloc) {
            __builtin_amdgcn_fence(__ATOMIC_RELEASE, "agent");
            asm volatile("s_waitcnt vmcnt(0)" ::: "memory");
            const unsigned og = xb_add(&bar[XB_TOP], 1u);
            const unsigned tg = og / nx;
            if (og + 1u == (tg + 1u) * nx) xb_add(&bar[XB_TOPGEN], 1u);
            else XB_SPIN(xb_ld(&bar[XB_TOPGEN]) == tg, bar);
            __builtin_amdgcn_fence(__ATOMIC_ACQUIRE, "agent");
            xb_add(&bar[XB_XGEN(b.x)], 1u);
            asm volatile("s_waitcnt vmcnt(0)" ::: "memory");
        } else {
            XB_SPIN(xb_ld(&bar[XB_XGEN(b.x)]) == gen, bar);
            __builtin_amdgcn_fence(__ATOMIC_ACQUIRE, "agent");
            asm volatile("s_waitcnt vmcnt(0)" ::: "memory");
        }
    }
    __syncthreads();
}

__device__ __forceinline__ void p0_transpose_item(const float* W, int K, int N, bf16_t* WT, int dst_row0, const float* gk, LAS float* scr, int k0, int n0, int lane) {
    f32x4 v[16];
#pragma unroll
    for (int i = 0; i < 16; ++i) { const int kk = 4 * i + (lane >> 4); v[i] = *(const f32x4*)(W + (size_t)(k0 + kk) * N + n0 + 4 * (lane & 15)); }
    if (gk) {
#pragma unroll
        for (int i = 0; i < 16; ++i) { const int kk = 4 * i + (lane >> 4); v[i] = v[i] * gk[k0 + kk]; }
    }
#pragma unroll
    for (int i = 0; i < 16; ++i) { const int kk = 4 * i + (lane >> 4); *(LAS f32x4*)(scr + kk * 68 + ((4 * (lane & 15)) ^ (4 * ((kk >> 3) & 7)))) = v[i]; }
    LDS_WAIT(); asm volatile("" ::: "memory");
    const int c = lane & 7, nl = lane >> 3;
#pragma unroll
    for (int j = 0; j < 8; ++j) { const int n = nl + 8 * j; const LAS float* sp = scr + (8 * c) * 68 + (n ^ (4 * c));
        u32x4 o; o.x = cvt_pk_bf16(sp[0 * 68], sp[1 * 68]); o.y = cvt_pk_bf16(sp[2 * 68], sp[3 * 68]); o.z = cvt_pk_bf16(sp[4 * 68], sp[5 * 68]); o.w = cvt_pk_bf16(sp[6 * 68], sp[7 * 68]);
        *(u32x4*)(WT + (size_t)(dst_row0 + n) * K + k0 + 8 * c) = o; }
    LDS_WAIT(); asm volatile("" ::: "memory");
}
template <bool SWIGLU>
__device__ __forceinline__ bool p0_matrix(int& r, const float* W, int K, int N, bf16_t* WT, const float* gk, LAS float* scr, int lane) {
    const int nblk = N / 64, items = (K / 64) * nblk;
    if (r >= items) { r -= items; return false; }
    const int kb = r / nblk, nb = r % nblk, n0 = 64 * nb; int dst0 = n0;
    if (SWIGLU) { const int bj = n0 >= DFF ? 1 : 0, j = n0 - bj * DFF; dst0 = 256 * (j >> 7) + 128 * bj + (j & 127); }
    p0_transpose_item(W, K, N, WT, dst0, gk, scr, 64 * kb, n0, lane);
    return true;
}
__device__ __forceinline__ void p0_prologue(const Args& a, LAS unsigned char* lds, int gw, int NGW, int wave, int lane) {
    LAS float* scr = (LAS float*)(lds + wave * 17408);
    unsigned char* ws = a.ws;
    constexpr int ITEMS_L = 1408 + 704 + 512 + 256 + 256 + 512 + 256 + 1408 + 704;
    for (int it = gw; it < 2 * ITEMS_L; it += NGW) {
        const int l = it / ITEMS_L; int r = it % ITEMS_L;
        unsigned char* wl = ws + WS_W + (size_t)l * W_LAYER;
        if (p0_matrix<true>(r, a.in[3] + (size_t)l * D * 2 * DFF, D, 2 * DFF, (bf16_t*)(wl + W_1IN), a.in[2] + l * D, scr, lane)) continue;
        if (p0_matrix<false>(r, a.in[4] + (size_t)l * DFF * D, DFF, D, (bf16_t*)(wl + W_1OUT), nullptr, scr, lane)) continue;
        if (p0_matrix<false>(r, a.in[6] + (size_t)l * D * DZ, D, DZ, (bf16_t*)(wl + W_MIXIN), a.in[5] + l * D, scr, lane)) continue;
        if (p0_matrix<false>(r, a.in[16] + (size_t)l * D * D, D, D, (bf16_t*)(wl + W_MIXOUT), nullptr, scr, lane)) continue;
        if (p0_matrix<false>(r, a.in[19] + (size_t)l * D * D, D, D, (bf16_t*)(wl + W_Q), a.in[17] + l * D, scr, lane)) continue;
        if (p0_matrix<false>(r, a.in[20] + (size_t)l * D * 2 * D, D, 2 * D, (bf16_t*)(wl + W_KV), nullptr, scr, lane)) continue;
        if (p0_matrix<false>(r, a.in[21] + (size_t)l * D * D, D, D, (bf16_t*)(wl + W_O), nullptr, scr, lane)) continue;
        if (p0_matrix<true>(r, a.in[23] + (size_t)l * D * 2 * DFF, D, 2 * DFF, (bf16_t*)(wl + W_2IN), a.in[22] + l * D, scr, lane)) continue;
        p0_matrix<false>(r, a.in[24] + (size_t)l * DFF * D, DFF, D, (bf16_t*)(wl + W_2OUT), nullptr, scr, lane);
    }
    bf16_t* XB = (bf16_t*)(ws + WS_XB); float* SS = (float*)(ws + WS_SS);
    for (int m = gw; m < M; m += NGW) {
        const f32x4* xr = (const f32x4*)(a.in[0] + (size_t)m * D) + lane; float s = 0.f;
        unsigned long long* o8 = (unsigned long long*)(XB + (size_t)m * D) + lane;
#pragma unroll
        for (int j = 0; j < 4; ++j) { const f32x4 v = xr[64 * j]; s += (v[0] * v[0] + v[1] * v[1]) + (v[2] * v[2] + v[3] * v[3]);
            o8[64 * j] = (unsigned long long)cvt_pk_bf16(v[0], v[1]) | ((unsigned long long)cvt_pk_bf16(v[2], v[3]) << 32); }
        s = wave_sum(s);
        if (lane < 4) SS[(size_t)m * 4 + lane] = lane == 0 ? s : 0.f;
    }
    for (int m = gw; m < 2 * BATCH * NMEM; m += NGW) {
        const int l = m / (BATCH * NMEM), rr = m % (BATCH * NMEM);
        const f32x4* xr = (const f32x4*)(a.in[1] + (size_t)rr * D) + lane; const f32x4* gr = (const f32x4*)(a.in[18] + l * D) + lane; f32x4 v[4]; float s = 0.f;
#pragma unroll
        for (int j = 0; j < 4; ++j) { v[j] = xr[64 * j]; s += (v[j][0] * v[j][0] + v[j][1] * v[j][1]) + (v[j][2] * v[j][2] + v[j][3] * v[j][3]); }
        const float rs = 1.0f / sqrtf(wave_sum(s) * (1.0f / D) + 1e-6f);
        unsigned long long* o8 = (unsigned long long*)((bf16_t*)(ws + WS_MEMN) + (size_t)m * D) + lane;
#pragma unroll
        for (int j = 0; j < 4; ++j) { const f32x4 g = gr[64 * j]; const f32x4 y = v[j] * rs * g;
            o8[64 * j] = (unsigned long long)cvt_pk_bf16(y[0], y[1]) | ((unsigned long long)cvt_pk_bf16(y[2], y[3]) << 32); }
    }
}

__device__ __forceinline__ f32x4 bf4_lo(const u32x4 u) { return (f32x4){bf_lo(u.x), bf_hi(u.x), bf_lo(u.y), bf_hi(u.y)}; }
__device__ __forceinline__ f32x4 bf4_hi(const u32x4 u) { return (f32x4){bf_lo(u.z), bf_hi(u.z), bf_lo(u.w), bf_hi(u.w)}; }
__device__ __forceinline__ void mixer_a(const bf16_t* Z, bf16_t* Y, const float* sw, int ch, int tid) {
    const int m0 = ch * 128, t0 = m0 & (SEQ - 1);
    const int cg8 = tid & 31, c = 8 * cg8;
    const f32x4 w0l = *(const f32x4*)(sw + c), w0h = *(const f32x4*)(sw + c + 4), w1l = *(const f32x4*)(sw + 256 + c), w1h = *(const f32x4*)(sw + 256 + c + 4), w2l = *(const f32x4*)(sw + 512 + c), w2h = *(const f32x4*)(sw + 512 + c + 4);
#pragma unroll 2
    for (int it = 0; it < 8; ++it) {
        const int tl = (tid >> 5) + 16 * it, tpos = t0 + tl; const bf16_t* zr = Z + (size_t)(m0 + tl) * DZ + c;
        const u32x4 zero = (u32x4){0u, 0u, 0u, 0u};
        const u32x4 ub = *(const u32x4*)zr, uc0 = *(const u32x4*)(zr + 256), ux0 = *(const u32x4*)(zr + 512);
        const u32x4 uc1 = tpos >= 1 ? *(const u32x4*)(zr - DZ + 256) : zero, ux1 = tpos >= 1 ? *(const u32x4*)(zr - DZ + 512) : zero;
        const u32x4 uc2 = tpos >= 2 ? *(const u32x4*)(zr - 2 * DZ + 256) : zero, ux2 = tpos >= 2 ? *(const u32x4*)(zr - 2 * DZ + 512) : zero;
        const f32x4 yl = bf4_lo(ub) * (w0l * (bf4_lo(uc2) * bf4_lo(ux2)) + w1l * (bf4_lo(uc1) * bf4_lo(ux1)) + w2l * (bf4_lo(uc0) * bf4_lo(ux0)));
        const f32x4 yh = bf4_hi(ub) * (w0h * (bf4_hi(uc2) * bf4_hi(ux2)) + w1h * (bf4_hi(uc1) * bf4_hi(ux1)) + w2h * (bf4_hi(uc0) * bf4_hi(ux0)));
        u32x4 o; o.x = cvt_pk_bf16(yl[0], yl[1]); o.y = cvt_pk_bf16(yl[2], yl[3]); o.z = cvt_pk_bf16(yh[0], yh[1]); o.w = cvt_pk_bf16(yh[2], yh[3]);
        *(u32x4*)(Y + (size_t)(m0 + tl) * D + c) = o;
    }
}
__device__ __forceinline__ void mixer_d(const bf16_t* Z, bf16_t* Y, const float* pw, const float* pscale, LAS unsigned char* lds, int hd, int tid) {
    constexpr int PS = 264;
    LAS bf16_t* WT = (LAS bf16_t*)lds;
    LAS bf16_t* PL = (LAS bf16_t*)(lds + 40960);
    const int m0 = hd * 64, t0 = m0 & (SEQ - 1);
#pragma unroll
    for (int it = 0; it < 5; ++it) { const int idx = tid + NTHR * it; if (idx < 79 * 32) { const int r = idx >> 5, cg8 = idx & 31;
            u32x4 v = (u32x4){0u, 0u, 0u, 0u}; if (t0 - 15 + r >= 0) v = *(const u32x4*)(Z + (size_t)(m0 - 15 + r) * DZ + 1792 + 8 * cg8);
            *(LAS u32x4*)(WT + r * 256 + 8 * cg8) = v; } }
    __syncthreads();
    {
        const int cp = tid & 127, tg = tid >> 7, c = 2 * cp, k = 2 << (c >> 6);
        const int r0 = 15 + 16 * tg, tpos = t0 + 16 * tg;
        float sa = 0.f, sb = 0.f;
        for (int j = 1; j < k; ++j) { const unsigned u = *(const LAS unsigned*)(WT + (r0 - j) * 256 + c); sa += bf_lo(u); sb += bf_hi(u); }
#pragma unroll 4
        for (int i = 0; i < 16; ++i) {
            const unsigned u = *(const LAS unsigned*)(WT + (r0 + i) * 256 + c); const float wa = bf_lo(u), wb = bf_hi(u);
            sa += wa; sb += wb;
            const int cnt = (tpos + i + 1 < k) ? (tpos + i + 1) : k; const float inv = 1.0f / (float)cnt;
            *(LAS unsigned*)(PL + (16 * tg + i) * PS + c) = cvt_pk_bf16(sa * inv - wa, sb * inv - wb);
            const unsigned u2 = *(const LAS unsigned*)(WT + (r0 + i - (k - 1)) * 256 + c); sa -= bf_lo(u2); sb -= bf_hi(u2);
        }
    }
    __syncthreads();
    {
        const int wave = tid >> 6, lane = tid & 63, fr = lane & 15, fq = lane >> 4, g = wave >> 1, th = wave & 1;
        f32x4 acc[2][4];
#pragma unroll
        for (int mt = 0; mt < 2; ++mt)
#pragma unroll
            for (int nt = 0; nt < 4; ++nt) acc[mt][nt] = (f32x4){0.f, 0.f, 0.f, 0.f};
#pragma unroll
        for (int ks = 0; ks < 2; ++ks) {
            bf16x8 pf[2];
#pragma unroll
            for (int mt = 0; mt < 2; ++mt) pf[mt] = *(const LAS bf16x8*)(PL + (32 * th + 16 * mt + fr) * PS + g * 64 + 32 * ks + 8 * fq);
#pragma unroll
            for (int nt = 0; nt < 4; ++nt) { const float* wp = pw + ((size_t)g * 64 + 32 * ks + 8 * fq) * 64 + 16 * nt + fr;
                u32x4 wu; wu.x = cvt_pk_bf16(wp[0], wp[64]); wu.y = cvt_pk_bf16(wp[128], wp[192]); wu.z = cvt_pk_bf16(wp[256], wp[320]); wu.w = cvt_pk_bf16(wp[384], wp[448]);
                const bf16x8 wf = __builtin_bit_cast(bf16x8, wu);
#pragma unroll
                for (int mt = 0; mt < 2; ++mt) acc[mt][nt] = __builtin_amdgcn_mfma_f32_16x16x32_bf16(wf, pf[mt], acc[mt][nt], 0, 0, 0); }
        }
#pragma unroll
        for (int nt = 0; nt < 4; ++nt) { const int d0 = g * 64 + 16 * nt + 4 * fq; const f32x4 sc = *(const f32x4*)(pscale + d0);
#pragma unroll
            for (int mt = 0; mt < 2; ++mt) { const int t = 32 * th + 16 * mt + fr; const f32x4 y = acc[mt][nt] * sc;
                u32x2 o; o.x = cvt_pk_bf16(y[0], y[1]); o.y = cvt_pk_bf16(y[2], y[3]);
                *(u32x2*)(Y + (size_t)(m0 + t) * D + 768 + d0) = o; } }
    }
    __syncthreads();
}
__device__ __forceinline__ void mixer_c(const bf16_t* Z, bf16_t* Y, const float* cw, const float* lng, const float* lnb, LAS unsigned char* lds, int hc, int tid) {
    LAS float* GL = (LAS float*)lds;
    const int m0 = hc * 64, t0 = m0 & (SEQ - 1);
#pragma unroll 3
    for (int it = 0; it < 6; ++it) { const int idx = tid + NTHR * it; if (idx < 94 * 32) { const int r = idx >> 5, cg8 = idx & 31;
            f32x4 gl = (f32x4){0.f, 0.f, 0.f, 0.f}, gh = gl;
            if (t0 - 30 + r >= 0) { const bf16_t* zr = Z + (size_t)(m0 - 30 + r) * DZ + 8 * cg8; const u32x4 ua = *(const u32x4*)(zr + 1280), ug = *(const u32x4*)(zr + 1536);
                const f32x4 al = bf4_lo(ua), ah = bf4_hi(ua), sl = bf4_lo(ug), sh = bf4_hi(ug);
#pragma unroll
                for (int e = 0; e < 4; ++e) { gl[e] = al[e] * __builtin_amdgcn_rcpf(1.0f + __expf(-sl[e])); gh[e] = ah[e] * __builtin_amdgcn_rcpf(1.0f + __expf(-sh[e])); } }
            *(LAS f32x4*)(GL + r * 256 + 8 * cg8) = gl; *(LAS f32x4*)(GL + r * 256 + 8 * cg8 + 4) = gh; } }
    __syncthreads();
    float outv[2][16];
    const int c = tid & 255;
    {
        float w[31];
#pragma unroll
        for (int k = 0; k < 31; ++k) w[k] = cw[k * 256 + c];
#pragma unroll
        for (int it = 0; it < 2; ++it) { const int tg = (tid >> 8) + 2 * it; float gv[46];
#pragma unroll
            for (int j = 0; j < 46; ++j) gv[j] = GL[(16 * tg + j) * 256 + c];
#pragma unroll
            for (int j = 0; j < 16; ++j) { float acc = 0.f;
#pragma unroll
                for (int k = 0; k < 31; ++k) acc += w[k] * gv[j + k];
                outv[it][j] = acc; } }
    }
    __syncthreads();
#pragma unroll
    for (int it = 0; it < 2; ++it) { const int tg = (tid >> 8) + 2 * it;
#pragma unroll
        for (int j = 0; j < 16; ++j) GL[(16 * tg + j) * 256 + c] = outv[it][j]; }
    __syncthreads();
    {
        const int wave = tid >> 6, lane = tid & 63;
        const f32x4 g4 = *(const f32x4*)(lng + 4 * lane), b4 = *(const f32x4*)(lnb + 4 * lane);
#pragma unroll
        for (int i = 0; i < 8; ++i) { const int tt = wave * 8 + i; f32x4 v = *(const LAS f32x4*)(GL + tt * 256 + 4 * lane);
            const float mu = wave_sum((v[0] + v[1]) + (v[2] + v[3])) * (1.0f / 256.0f); v = v - mu;
            const float var = wave_sum((v[0] * v[0] + v[1] * v[1]) + (v[2] * v[2] + v[3] * v[3])) * (1.0f / 256.0f);
            const float rs = 1.0f / sqrtf(var + 1e-6f); f32x4 y = v * rs * g4 + b4;
            y[0] = pg8::fast_silu(y[0]); y[1] = pg8::fast_silu(y[1]); y[2] = pg8::fast_silu(y[2]); y[3] = pg8::fast_silu(y[3]);
            u32x2 o; o.x = cvt_pk_bf16(y[0], y[1]); o.y = cvt_pk_bf16(y[2], y[3]);
            *(u32x2*)(Y + (size_t)(m0 + tt) * D + 512 + 4 * lane) = o; }
    }
    __syncthreads();
}
__device__ __forceinline__ void mixer_b(const bf16_t* Z, bf16_t* Y, const float* ng, const float* wsg, const float* bs, LAS unsigned char* lds, int ch, int tid) {
    constexpr int VS = 136;
    LAS bf16_t* VT = (LAS bf16_t*)lds;
    const int m0 = ch * 128, wave = tid >> 6, lane = tid & 63, fr = lane & 15, fq = lane >> 4;
    {
        const f32x4 g4 = *(const f32x4*)(ng + 4 * lane);
        unsigned pk[4][8];
#pragma unroll
        for (int j2 = 0; j2 < 8; ++j2) { float y[2][4];
#pragma unroll
            for (int e = 0; e < 2; ++e) { const int s = 16 * wave + 2 * j2 + e; const u32x2 u = *(const u32x2*)(Z + (size_t)(m0 + s) * DZ + 1024 + 4 * lane);
                f32x4 v = (f32x4){bf_lo(u.x), bf_hi(u.x), bf_lo(u.y), bf_hi(u.y)};
                const float mu = wave_sum((v[0] + v[1]) + (v[2] + v[3])) * (1.0f / 256.0f); v = v - mu;
                const float var = wave_sum((v[0] * v[0] + v[1] * v[1]) + (v[2] * v[2] + v[3] * v[3])) * (1.0f / 256.0f);
                const float rs = 1.0f / sqrtf(var + 1e-6f); const f32x4 o = v * rs * g4;
                y[e][0] = o[0]; y[e][1] = o[1]; y[e][2] = o[2]; y[e][3] = o[3]; }
#pragma unroll
            for (int i = 0; i < 4; ++i) pk[i][j2] = cvt_pk_bf16(y[0][i], y[1][i]); }
#pragma unroll
        for (int i = 0; i < 4; ++i) { LAS u32x4* dst = (LAS u32x4*)(VT + (4 * lane + i) * VS + 16 * wave);
            dst[0] = (u32x4){pk[i][0], pk[i][1], pk[i][2], pk[i][3]}; dst[1] = (u32x4){pk[i][4], pk[i][5], pk[i][6], pk[i][7]}; }
    }
    __syncthreads();
    {
        const int h = wave >> 1, th = wave & 1;
        f32x4 acc[4][4];
#pragma unroll
        for (int mt = 0; mt < 4; ++mt)
#pragma unroll
            for (int nt = 0; nt < 4; ++nt) acc[mt][nt] = (f32x4){0.f, 0.f, 0.f, 0.f};
#pragma unroll
        for (int ks = 0; ks < 4; ++ks) {
            if (32 * ks > 64 * th + 63) continue;
            bf16x8 bfr[4];
#pragma unroll
            for (int nt = 0; nt < 4; ++nt) bfr[nt] = *(const LAS bf16x8*)(VT + (h * 64 + 16 * nt + fr) * VS + 32 * ks + 8 * fq);
#pragma unroll
            for (int mt = 0; mt < 4; ++mt) { const int t = 64 * th + 16 * mt + fr, s = 32 * ks + 8 * fq;
                const f32x4* wp = (const f32x4*)(wsg + ((size_t)h * 128 + t) * 128 + s); f32x4 w0 = wp[0], w1 = wp[1];
#pragma unroll
                for (int e = 0; e < 4; ++e) { if (s + e > t) w0[e] = 0.f; if (s + 4 + e > t) w1[e] = 0.f; }
                u32x4 au; au.x = cvt_pk_bf16(w0[0], w0[1]); au.y = cvt_pk_bf16(w0[2], w0[3]); au.z = cvt_pk_bf16(w1[0], w1[1]); au.w = cvt_pk_bf16(w1[2], w1[3]);
                const bf16x8 afr = __builtin_bit_cast(bf16x8, au);
#pragma unroll
                for (int nt = 0; nt < 4; ++nt) acc[mt][nt] = __builtin_amdgcn_mfma_f32_16x16x32_bf16(bfr[nt], afr, acc[mt][nt], 0, 0, 0); }
        }
#pragma unroll
        for (int mt = 0; mt < 4; ++mt) { const int t = 64 * th + 16 * mt + fr; const float bias = bs[h * 128 + t];
#pragma unroll
            for (int nt = 0; nt < 4; ++nt) { const int d0 = h * 64 + 16 * nt + 4 * fq; const u32x2 u = *(const u32x2*)(Z + (size_t)(m0 + t) * DZ + 768 + d0);
                const f32x4 a = acc[mt][nt]; u32x2 o; o.x = cvt_pk_bf16(bf_lo(u.x) * (a[0] + bias), bf_hi(u.x) * (a[1] + bias)); o.y = cvt_pk_bf16(bf_lo(u.y) * (a[2] + bias), bf_hi(u.y) * (a[3] + bias));
                *(u32x2*)(Y + (size_t)(m0 + t) * D + 256 + d0) = o; } }
    }
    __syncthreads();
}

__global__ void __launch_bounds__(NTHR, 2) mk_fwd(Args args) {
    extern __shared__ __attribute__((aligned(16))) unsigned char lds_raw[];
    LAS unsigned char* lds = (LAS unsigned char*)lds_raw;
    const int tid = threadIdx.x, lane = tid & 63, wave = __builtin_amdgcn_readfirstlane(tid >> 6);
    const int G = gridDim.x, bx = blockIdx.x;
    const int gw = bx * NWAVES + wave, NGW = G * NWAVES;
    unsigned char* ws = args.ws;
    float* X = args.out;
    bf16_t* XB = (bf16_t*)(ws + WS_XB); float* SS = (float*)(ws + WS_SS);
    bf16_t* ACT = (bf16_t*)(ws + WS_R + R_ACT); bf16_t* Zb = (bf16_t*)(ws + WS_R + R_Z); bf16_t* Yb = (bf16_t*)(ws + WS_R + R_Y);
    bf16_t* Qb = (bf16_t*)(ws + WS_R + R_Q); bf16_t* Pb = (bf16_t*)(ws + WS_R + R_P); bf16_t* Ob = (bf16_t*)(ws + WS_R + R_O);
    const int lo = args.ph_lo, hi = args.ph_hi;
    cg::grid_group grid = cg::this_grid();
    volatile LAS unsigned* bst = (volatile LAS unsigned*)(lds + RING_BYTES + 8192);
    if (tid < 2) bst[tid] = 0u;
    __syncthreads();
    XcdBarrier xbar; xbar.bar = (unsigned*)(ws + WS_CTL); xbar.x = 0; xbar.st = bst;
    if (hi - lo > 1) xbar = xcd_barrier_post((unsigned*)(ws + WS_CTL), bst);
    if (lo < 0) grid.sync();
#define IN(k) (lo <= (k) && (k) < hi)
#define SEAM(k) do { if (IN(k) && IN((k) + 1)) { xcd_barrier(xbar); if (PROBE_MASK & (1 << 10)) xcd_barrier(xbar); } } while (0)
#define REP(cls) for (int rep_ = 0; rep_ < ((PROBE_MASK >> (cls)) & 1) + 1; ++rep_)

    if (IN(0)) REP(0) p0_prologue(args, lds, gw, NGW, wave, lane);
    SEAM(0);
#pragma unroll 1
    for (int l = 0; l < 2; ++l) {
        const int pb = 1 + 11 * l;
        unsigned char* wl = ws + WS_W + (size_t)l * W_LAYER;
        if (IN(pb + 0)) {
            REP(1) { pg8::Gemm g = pg8::plain_gemm(XB, (const bf16_t*)(wl + W_1IN), D); pg8::StaticOrder S; S.init(M, 2 * DFF, G, bx);
              pg8::EpiSwiGLU E{ACT, SS}; pg8::gemm_phase<pg8::EpiSwiGLU, pg8::StaticOrder, true>(lds, g, S, E); }
            if (l == 0) {
                for (int kk = 0; kk < 4; ++kk) { const int ll = kk >> 1, isv = kk & 1; const int c2 = (bx + 2 * G - 128 - 32 * kk) % G;
                    const bf16_t* memn = (const bf16_t*)(ws + WS_MEMN) + (size_t)ll * 1024 * D; const bf16_t* wkv = (const bf16_t*)(ws + WS_W + (size_t)ll * W_LAYER + W_KV);
                    pg8::StaticOrder S; S.init(1024, 1024, G, c2);
                    if (!isv) { pg8::Gemm g = pg8::plain_gemm(memn, wkv, D); pg8::EpiBf16 E{(bf16_t*)(ws + WS_KB) + (size_t)ll * 1024 * 1024, 1024, nullptr, 1.0f};
                        pg8::gemm_phase<pg8::EpiBf16, pg8::StaticOrder, true>(lds, g, S, E); }
                    else { pg8::Gemm g = pg8::plain_gemm(wkv + (size_t)1024 * D, memn, D); pg8::EpiBf16 E{(bf16_t*)(ws + WS_VT) + (size_t)ll * 1024 * 1024, 1024, nullptr, 1.0f};
                        pg8::gemm_phase<pg8::EpiBf16, pg8::StaticOrder, true>(lds, g, S, E); } }
            }
        }
        SEAM(pb + 0);
        if (IN(pb + 1)) REP(2) { pg8::Gemm g = pg8::plain_gemm(ACT, (const bf16_t*)(wl + W_1OUT), DFF); pg8::StaticOrder S; S.init(M, D, G, bx);
            pg8::EpiResid E{(l == 0 && rep_ == 0) ? args.in[0] : X, X, XB, SS, rep_ == 0 ? 0.5f : 0.f}; pg8::gemm_phase<pg8::EpiResid, pg8::StaticOrder, true>(lds, g, S, E); }
        SEAM(pb + 1);
        if (IN(pb + 2)) REP(3) { pg8::Gemm g = pg8::plain_gemm(XB, (const bf16_t*)(wl + W_MIXIN), D); pg8::StaticOrder S; S.init(M, DZ, G, bx);
            pg8::EpiBf16 E{Zb, DZ, SS, 1.0f}; pg8::gemm_phase<pg8::EpiBf16, pg8::StaticOrder, true>(lds, g, S, E); }
        SEAM(pb + 2);
        if (IN(pb + 3)) REP(4) {
            for (int u = bx; u < 768; u += G) {
                int ptid = tid; asm volatile("" : "+v"(ptid));
                if (u < 256) mixer_c(Zb, Yb, args.in[11] + l * 31 * 256, args.in[12] + l * 256, args.in[13] + l * 256, lds, u, ptid);
                else if (u < 512) mixer_d(Zb, Yb, args.in[14] + (size_t)l * 4 * 64 * 64, args.in[15] + l * 256, lds, u - 256, ptid);
                else if (u < 640) mixer_b(Zb, Yb, args.in[8] + l * 256, args.in[9] + (size_t)l * 4 * 128 * 128, args.in[10] + l * 4 * 128, lds, u - 512, ptid);
                else mixer_a(Zb, Yb, args.in[7] + l * 3 * 256, u - 640, ptid);
            }
        }
        SEAM(pb + 3);
        if (IN(pb + 4)) REP(5) { pg8::Gemm g = pg8::plain_gemm(Yb, (const bf16_t*)(wl + W_MIXOUT), D); pg8::StaticOrder S; S.init(M, D, G, bx);
            pg8::EpiResid E{X, X, XB, SS, rep_ == 0 ? 1.0f : 0.f}; pg8::gemm_phase<pg8::EpiResid, pg8::StaticOrder, true>(lds, g, S, E); }
        SEAM(pb + 4);
        if (IN(pb + 5)) REP(6) { pg8::Gemm g = pg8::plain_gemm(XB, (const bf16_t*)(wl + W_Q), D); pg8::StaticOrder S; S.init(M, D, G, bx);
            pg8::EpiBf16 E{Qb, D, SS, QSCALE}; pg8::gemm_phase<pg8::EpiBf16, pg8::StaticOrder, true>(lds, g, S, E); }
        SEAM(pb + 5);
        if (IN(pb + 6)) REP(7) { pg8::Gemm g; g.A = Qb; g.Bt = (const bf16_t*)(ws + WS_KB) + (size_t)l * 1024 * 1024; g.lda = 1024; g.ldb = 1024; g.K = 256;
            g.a_pm = 256L * 1024; g.a_pn = 256; g.b_pn = 256; g.b_pb = 256L * 1024;
            pg8::StaticOrder S; S.init(M, D, G, bx); pg8::EpiSoftmax E{Pb}; pg8::gemm_phase<pg8::EpiSoftmax, pg8::StaticOrder, false>(lds, g, S, E); }
        SEAM(pb + 6);
        if (IN(pb + 7)) REP(8) { pg8::Gemm g; g.A = Pb; g.Bt = (const bf16_t*)(ws + WS_VT) + (size_t)l * 1024 * 1024; g.lda = 1024; g.ldb = 1024; g.K = 256;
            g.a_pm = 256L * 1024; g.a_pn = 256; g.b_pn = 256L * 1024; g.b_pb = 256;
            pg8::StaticOrder S; S.init(M, D, G, bx); pg8::EpiBf16 E{Ob, D, nullptr, 1.0f}; pg8::gemm_phase<pg8::EpiBf16, pg8::StaticOrder, true>(lds, g, S, E); }
        SEAM(pb + 7);
        if (IN(pb + 8)) REP(9) { pg8::Gemm g = pg8::plain_gemm(Ob, (const bf16_t*)(wl + W_O), D); pg8::StaticOrder S; S.init(M, D, G, bx);
            pg8::EpiResid E{X, X, XB, SS, rep_ == 0 ? 1.0f : 0.f}; pg8::gemm_phase<pg8::EpiResid, pg8::StaticOrder, true>(lds, g, S, E); }
        SEAM(pb + 8);
        if (IN(pb + 9)) REP(1) { pg8::Gemm g = pg8::plain_gemm(XB, (const bf16_t*)(wl + W_2IN), D); pg8::StaticOrder S; S.init(M, 2 * DFF, G, bx);
            pg8::EpiSwiGLU E{ACT, SS}; pg8::gemm_phase<pg8::EpiSwiGLU, pg8::StaticOrder, true>(lds, g, S, E); }
        SEAM(pb + 9);
        if (IN(pb + 10)) REP(2) { pg8::Gemm g = pg8::plain_gemm(ACT, (const bf16_t*)(wl + W_2OUT), DFF); pg8::StaticOrder S; S.init(M, D, G, bx);
            pg8::EpiResid E{X, X, XB, SS, rep_ == 0 ? 0.5f : 0.f}; pg8::gemm_phase<pg8::EpiResid, pg8::StaticOrder, true>(lds, g, S, E); }
        SEAM(pb + 10);
    }
    if (IN(23)) {
        const f32x4* gf = (const f32x4*)args.in[25] + lane;
        for (int m = gw; m < M; m += NGW) { const float rs = pg8::row_rs(SS, m); f32x4* xr = (f32x4*)(X + (size_t)m * D) + lane;
#pragma unroll
            for (int j = 0; j < 4; ++j) xr[64 * j] = xr[64 * j] * rs * gf[64 * j]; }
    }
#undef IN
#undef SEAM
#undef REP
}
}
#define MK_MODE 0

#ifndef MK_MODE
#define MK_MODE 0
#endif
extern "C" void kernel_launch(void* const* d_in, const int* in_sizes, int n_in, void* d_out, int out_size, void* d_ws, size_t ws_size, hipStream_t stream) {
    using namespace mk;
    static int grid = 0;
    if (grid == 0) {
        if (n_in != 26 || out_size != M * D || ws_size < WS_END) { fprintf(stderr, "kernel_launch: unexpected shapes (n_in %d out %d ws %zu)\n", n_in, out_size, ws_size); grid = -1; return; }
        int dev = 0, cus = 0, per_cu = 0;
        hipGetDevice(&dev); hipDeviceGetAttribute(&cus, hipDeviceAttributeMultiprocessorCount, dev);
        if (hipFuncSetAttribute((const void*)mk_fwd, hipFuncAttributeMaxDynamicSharedMemorySize, LDS_BYTES) != hipSuccess) { fprintf(stderr, "kernel_launch: hipFuncSetAttribute failed\n"); grid = -1; return; }
        if (hipOccupancyMaxActiveBlocksPerMultiprocessor(&per_cu, (const void*)mk_fwd, NTHR, LDS_BYTES) != hipSuccess || per_cu < 1) { fprintf(stderr, "kernel_launch: occupancy query failed (%d)\n", per_cu); per_cu = 1; }
        (void)hipGetLastError();
        grid = cus * per_cu;
        fprintf(stderr, "kernel_launch: cus %d per_cu %d grid %d\n", cus, per_cu, grid);
    }
    if (grid < 0) return;
    Args a{};
    for (int i = 0; i < 26; ++i) a.in[i] = (const float*)d_in[i];
    a.out = (float*)d_out; a.ws = (unsigned char*)d_ws;
#if MK_MODE == 0
    a.ph_lo = 0; a.ph_hi = NPH;
    if (hipMemsetAsync((char*)d_ws + WS_CTL, 0, 16384, stream) != hipSuccess) { fprintf(stderr, "kernel_launch: memset of the barrier words failed\n"); return; }
    void* kargs[] = {&a};
    hipError_t e = hipLaunchCooperativeKernel((const void*)mk_fwd, dim3(grid), dim3(NTHR), kargs, LDS_BYTES, stream);
    if (e != hipSuccess) fprintf(stderr, "kernel_launch: cooperative launch failed: %s (grid %d)\n", hipGetErrorString(e), grid);
#else
    for (int p = 0; p < NPH; ++p) { a.ph_lo = p; a.ph_hi = p + 1; hipLaunchKernelGGL(mk_fwd, dim3(grid), dim3(NTHR), LDS_BYTES, stream, a); }
#endif
}
```

```cpp
#include <hip/hip_runtime.h>
#include <hip/hip_cooperative_groups.h>
#include <cstdio>
#include <cstdint>
namespace cg = cooperative_groups;
namespace pg8 {
#define PG8_LAS __attribute__((address_space(3)))
typedef unsigned short bf16_t;
typedef short bf16x8 __attribute__((ext_vector_type(8)));
typedef float f32x4 __attribute__((ext_vector_type(4)));
typedef float f32x2 __attribute__((ext_vector_type(2)));
typedef unsigned u32x4 __attribute__((ext_vector_type(4)));
typedef unsigned u32x2 __attribute__((ext_vector_type(2)));
constexpr int LDR = 3072;
constexpr int BM = 256, BK = 64, HALF = 128, HTB = HALF * BK * 2, STAGE_BYTES = 8 * HTB, NXCD = 8, WGM = 8;

__host__ __device__ __forceinline__ int lds_byte(int r, int c) { const int st = (r >> 4) * 2 + (c >> 5), rr = r & 15, cc = c & 31, ob = rr * 64 + cc * 2; return st * 1024 + (ob ^ (((ob >> 9) & 1) << 5)); }
__host__ __device__ __forceinline__ void stage_rc(int b, int& R, int& C) { const int st = b / 1024, sb = b % 1024, swz = sb ^ (((sb >> 9) & 1) << 5); R = (st >> 1) * 16 + swz / 64; C = (st & 1) * 32 + (swz % 64) / 2; }
__host__ __device__ __forceinline__ int perm32(int rho) { const int n = rho >> 4, i = rho & 15; return 8 * (i >> 2) + 4 * n + (i & 3); }

struct Unit { int pm, pn; };
struct Gemm { const bf16_t* A; const bf16_t* Bt; int lda, ldb, K; long a_pm, a_pn, b_pn, b_pb, b_pm; };
__device__ __forceinline__ Gemm plain_gemm(const bf16_t* A, const bf16_t* Bt, int K) { Gemm g; g.A = A; g.Bt = Bt; g.lda = K; g.ldb = K; g.K = K; g.a_pm = 256L * K; g.a_pn = 0; g.b_pn = 256L * K; g.b_pb = 0; g.b_pm = 0; return g; }

struct StaticOrder {
    int nM, nN, nwg, G, c;
    __host__ __device__ void init(int M, int N, int G_, int c_) { nM = M / BM; nN = N / BM; nwg = nM * nN; G = G_; c = c_; }
    __host__ __device__ bool next(int i, Unit& u) const {
        const long L = (long)i * G + c; if (L >= nwg) return false;
        int wgid = (int)L; { const int q = nwg / NXCD, r = nwg % NXCD, xcd = wgid % NXCD, off = wgid / NXCD; wgid = (xcd < r ? xcd * (q + 1) : r * (q + 1) + (xcd - r) * q) + off; }
        const int nig = WGM * nN, gid = wgid / nig, fm = gid * WGM, gsz = (nM - fm) < WGM ? (nM - fm) : WGM;
        u.pm = fm + ((wgid % nig) % gsz); u.pn = (wgid % nig) / gsz; return true;
    }
};

typedef __bf16 bf16x2_n __attribute__((ext_vector_type(2)));
__device__ __forceinline__ unsigned cvt_pk_bf16(float lo, float hi) { const f32x2 v = {lo, hi}; return __builtin_bit_cast(unsigned, __builtin_convertvector(v, bf16x2_n)); }

#ifndef WT_STORES
#define WT_STORES 0
#endif
__device__ __forceinline__ void st16(void* p, u32x4 v) {
#if WT_STORES
    asm volatile("global_store_dwordx4 %0, %1, off sc1\n\ts_nop 1" :: "v"(p), "v"(v) : "memory");
#else
    *(u32x4*)p = v;
#endif
}
__device__ __forceinline__ float row_rs(const float* ss, int row) {
    const f32x4 a = *(const f32x4*)(ss + (size_t)row * 4);
    const float s = (a[0] + a[1]) + (a[2] + a[3]);
    return __builtin_amdgcn_rsqf(s * (1.0f / 1024.0f) + 1e-6f);
}
__device__ __forceinline__ float fast_silu(float g) { return g * __builtin_amdgcn_rcpf(1.0f + __expf(-g)); }


struct EpiBf16 {
    static constexpr bool PERM = true, AFTER_DRAIN = false, RESID_PREFETCH = false;
    bf16_t* O; int ldc; const float* ss; float scale; int tab_pm;
    __device__ __forceinline__ void operator()(const f32x4 (&acc)[2][2][4][2], const Unit& u, int wr, int wc, int fr, int fq, PG8_LAS unsigned char* spare, int tid) const {
        const int row0 = u.pm * BM + wr * 64 + fr, col0 = u.pn * BM + wc * 32 + 8 * fq; const PG8_LAS float* tab = (const PG8_LAS float*)(spare + 4096);
#pragma unroll
        for (int ai = 0; ai < 2; ++ai)
#pragma unroll
            for (int m = 0; m < 4; ++m) { const int row = row0 + ai * HALF + m * 16; const float sc = ss ? tab[row - u.pm * BM] * scale : scale;
                bf16_t* rowp = O + (size_t)row * ldc + col0;
#pragma unroll
                for (int bj = 0; bj < 2; ++bj) { const f32x4 v0 = acc[ai][bj][m][0] * sc, v1 = acc[ai][bj][m][1] * sc;
                    u32x4 w; w.x = cvt_pk_bf16(v0[0], v0[1]); w.y = cvt_pk_bf16(v0[2], v0[3]); w.z = cvt_pk_bf16(v1[0], v1[1]); w.w = cvt_pk_bf16(v1[2], v1[3]);
                    st16(rowp + bj * HALF, w); } }
    }
};
struct EpiSwiGLU {
    static constexpr bool PERM = true, AFTER_DRAIN = false, RESID_PREFETCH = false;
    bf16_t* O; const float* ss; int tab_pm;
    __device__ __forceinline__ void operator()(const f32x4 (&acc)[2][2][4][2], const Unit& u, int wr, int wc, int fr, int fq, PG8_LAS unsigned char* spare, int tid) const {
        const int row0 = u.pm * BM + wr * 64 + fr, col0 = u.pn * HALF + wc * 32 + 8 * fq; const PG8_LAS float* tab = (const PG8_LAS float*)(spare + 4096);
#pragma unroll
        for (int ai = 0; ai < 2; ++ai)
#pragma unroll
            for (int m = 0; m < 4; ++m) { const int row = row0 + ai * HALF + m * 16; const float sc = tab[row - u.pm * BM];
                const float sc2 = sc * sc, sce = sc * -1.4426950408889634f;
                f32x4 e0 = acc[ai][0][m][0] * sce, e1 = acc[ai][0][m][1] * sce;
#pragma unroll
                for (int e = 0; e < 4; ++e) { e0[e] = __builtin_amdgcn_exp2f(e0[e]); e1[e] = __builtin_amdgcn_exp2f(e1[e]); }
                e0 = e0 + 1.0f; e1 = e1 + 1.0f;
#pragma unroll
                for (int e = 0; e < 4; ++e) { e0[e] = __builtin_amdgcn_rcpf(e0[e]); e1[e] = __builtin_amdgcn_rcpf(e1[e]); }
                const f32x4 o0 = (acc[ai][0][m][0] * acc[ai][1][m][0]) * (e0 * sc2), o1 = (acc[ai][0][m][1] * acc[ai][1][m][1]) * (e1 * sc2);
                u32x4 w; w.x = cvt_pk_bf16(o0[0], o0[1]); w.y = cvt_pk_bf16(o0[2], o0[3]); w.z = cvt_pk_bf16(o1[0], o1[1]); w.w = cvt_pk_bf16(o1[2], o1[3]);
                st16(O + (size_t)row * LDR + col0, w); }
    }
};
struct EpiResid {
    static constexpr bool PERM = true, AFTER_DRAIN = true, RESID_PREFETCH = true;
    bf16_t* xb; float* ss; float alpha;
    __device__ __forceinline__ void fused(f32x4 (&acc)[2][2][4][2], const Unit& u, int wr, int wc, int fr, int fq, PG8_LAS unsigned char* lds, int wid, int lane) const {
        PG8_LAS float* Pq = (PG8_LAS float*)(lds + STAGE_BYTES);
        const int tid = wid * 64 + lane, h = wc >> 1;
        const int row0 = u.pm * BM + wr * 64 + fr, col0 = u.pn * BM + wc * 32 + 8 * fq;
        u32x4 g7[4];
        if (h) {
#pragma unroll
            for (int m = 0; m < 4; ++m) g7[m] = *(const u32x4*)(xb + (size_t)(row0 + HALF + m * 16) * 1024 + col0 + HALF);
        }
#pragma unroll
        for (int ai = 0; ai < 2; ++ai)
#pragma unroll
            for (int m = 0; m < 4; ++m) { const int row = row0 + ai * HALF + m * 16; bf16_t* rowp = xb + (size_t)row * 1024 + col0; float q = 0.f;
                const int poff = lds_byte(wr * 64 + m * 16 + fr, (wc & 1) * 32 + 8 * fq);
#pragma unroll
                for (int bj = 0; bj < 2; ++bj) {
                    const int slot = ai == 0 ? (bj == 0 ? 4 + h : h) : (bj == 0 ? 6 + h : 2);
                    u32x4 b = *(const PG8_LAS u32x4*)(lds + slot * HTB + poff);
                    if (ai == 1 && bj == 1) { if (h) b = g7[m]; }
                    const f32x4 o0 = (f32x4){__uint_as_float(b.x << 16), __uint_as_float(b.x & 0xffff0000u), __uint_as_float(b.y << 16), __uint_as_float(b.y & 0xffff0000u)} + acc[ai][bj][m][0] * alpha;
                    const f32x4 o1 = (f32x4){__uint_as_float(b.z << 16), __uint_as_float(b.z & 0xffff0000u), __uint_as_float(b.w << 16), __uint_as_float(b.w & 0xffff0000u)} + acc[ai][bj][m][1] * alpha;
                    u32x4 w; w.x = cvt_pk_bf16(o0[0], o0[1]); w.y = cvt_pk_bf16(o0[2], o0[3]); w.z = cvt_pk_bf16(o1[0], o1[1]); w.w = cvt_pk_bf16(o1[2], o1[3]);
                    st16(rowp + bj * HALF, w);
                    q += ((o0[0] * o0[0] + o0[1] * o0[1]) + (o0[2] * o0[2] + o0[3] * o0[3])) + ((o1[0] * o1[0] + o1[1] * o1[1]) + (o1[2] * o1[2] + o1[3] * o1[3])); }
                q += __shfl_xor(q, 16); q += __shfl_xor(q, 32);
                if (fq == 0) Pq[(ai * HALF + wr * 64 + m * 16 + fr) * 4 + wc] = q; }
        asm volatile("s_waitcnt lgkmcnt(0)" ::: "memory"); __builtin_amdgcn_s_barrier(); asm volatile("" ::: "memory");
        if (tid < 256) { const f32x4 v = *(const PG8_LAS f32x4*)(Pq + tid * 4); ss[(size_t)(u.pm * BM + tid) * 4 + u.pn] = (v[0] + v[1]) + (v[2] + v[3]); }
    }
};
struct EpiSoftmax {
    static constexpr bool PERM = true, AFTER_DRAIN = true, RESID_PREFETCH = false;
    bf16_t* P; const float* ss; float scale; int tab_pm;
    __device__ __forceinline__ void fused(f32x4 (&acc)[2][2][4][2], const Unit& u, int wr, int wc, int fr, int fq, PG8_LAS unsigned char* lds, int wid, int lane) const {
        PG8_LAS float* Pm = (PG8_LAS float*)lds;
        PG8_LAS float* Ps = (PG8_LAS float*)(lds + 4096);
#pragma unroll
        for (int ai = 0; ai < 2; ++ai)
#pragma unroll
            for (int m = 0; m < 4; ++m) { const int rt = ai * HALF + wr * 64 + m * 16 + fr; const float sc = ((const PG8_LAS float*)(lds + STAGE_BYTES + 4096))[rt] * scale;
#pragma unroll
                for (int bj = 0; bj < 2; ++bj)
#pragma unroll
                    for (int n = 0; n < 2; ++n) acc[ai][bj][m][n] = acc[ai][bj][m][n] * sc; }
#pragma unroll
        for (int ai = 0; ai < 2; ++ai)
#pragma unroll
            for (int m = 0; m < 4; ++m) { float mx = -3.0e38f;
#pragma unroll
                for (int bj = 0; bj < 2; ++bj)
#pragma unroll
                    for (int n = 0; n < 2; ++n) { const f32x4 x = acc[ai][bj][m][n]; mx = fmaxf(mx, fmaxf(fmaxf(x[0], x[1]), fmaxf(x[2], x[3]))); }
                mx = fmaxf(mx, __shfl_xor(mx, 16)); mx = fmaxf(mx, __shfl_xor(mx, 32));
                if (fq == 0) Pm[(ai * HALF + wr * 64 + m * 16 + fr) * 4 + wc] = mx; }
        asm volatile("s_waitcnt lgkmcnt(0)" ::: "memory"); __builtin_amdgcn_s_barrier(); asm volatile("" ::: "memory");
#pragma unroll
        for (int ai = 0; ai < 2; ++ai)
#pragma unroll
            for (int m = 0; m < 4; ++m) { const int r = ai * HALF + wr * 64 + m * 16 + fr; const f32x4 pm4 = *(const PG8_LAS f32x4*)(Pm + r * 4);
                const float mx = fmaxf(fmaxf(pm4[0], pm4[1]), fmaxf(pm4[2], pm4[3])); float s = 0.f;
#pragma unroll
                for (int bj = 0; bj < 2; ++bj)
#pragma unroll
                    for (int n = 0; n < 2; ++n) { f32x4 x = acc[ai][bj][m][n];
                        x[0] = __builtin_amdgcn_exp2f(x[0] - mx); x[1] = __builtin_amdgcn_exp2f(x[1] - mx); x[2] = __builtin_amdgcn_exp2f(x[2] - mx); x[3] = __builtin_amdgcn_exp2f(x[3] - mx);
                        acc[ai][bj][m][n] = x; s += (x[0] + x[1]) + (x[2] + x[3]); }
                s += __shfl_xor(s, 16); s += __shfl_xor(s, 32);
                if (fq == 0) Ps[r * 4 + wc] = s; }
        asm volatile("s_waitcnt lgkmcnt(0)" ::: "memory"); __builtin_amdgcn_s_barrier(); asm volatile("" ::: "memory");
        const int col0 = u.pn * BM + wc * 32 + 8 * fq;
#pragma unroll
        for (int ai = 0; ai < 2; ++ai)
#pragma unroll
            for (int m = 0; m < 4; ++m) { const int r = ai * HALF + wr * 64 + m * 16 + fr; const f32x4 ps4 = *(const PG8_LAS f32x4*)(Ps + r * 4);
                const float inv = 1.0f / ((ps4[0] + ps4[1]) + (ps4[2] + ps4[3]));
                bf16_t* rowp = P + (size_t)(u.pm * BM + r) * LDR + col0;
#pragma unroll
                for (int bj = 0; bj < 2; ++bj) { const f32x4 v0 = acc[ai][bj][m][0] * inv, v1 = acc[ai][bj][m][1] * inv;
                    u32x4 w; w.x = cvt_pk_bf16(v0[0], v0[1]); w.y = cvt_pk_bf16(v0[2], v0[3]); w.z = cvt_pk_bf16(v1[0], v1[1]); w.w = cvt_pk_bf16(v1[2], v1[3]);
                    st16(rowp + bj * HALF, w); } }
        asm volatile("s_waitcnt lgkmcnt(0)" ::: "memory"); __builtin_amdgcn_s_barrier(); asm volatile("" ::: "memory");
    }
};

template <class Epi, class Sched, bool ALIGN_EPI>
__device__ __forceinline__ void gemm_phase(PG8_LAS unsigned char* lds, const Gemm g, const Sched& S, const Epi& E) {
    int tid_ = threadIdx.x; asm volatile("" : "+v"(tid_));
    const int tid = tid_, wid = __builtin_amdgcn_readfirstlane(tid >> 6), lane = tid & 63, wr = wid >> 2, wc = wid & 3, fr = lane & 15, fq = lane >> 4;
    const int K = g.K, nt = K / BK;
    unsigned voffA[2], voffB[2];
#pragma unroll
    for (int i = 0; i < 2; ++i) { int R, C; stage_rc(tid * 16 + i * 8192, R, C); const int Rb = Epi::PERM ? ((R & ~31) + perm32(R & 31)) : R;
        voffA[i] = (unsigned)(R * g.lda + C) * 2u; voffB[i] = (unsigned)(Rb * g.ldb + C) * 2u; }
    const size_t kstep = (size_t)(BK * 2);
    const size_t hstepA = (size_t)HALF * g.lda * 2, hstepB = (size_t)HALF * g.ldb * 2;
    const unsigned ldsw = (unsigned)wid * 1024u;
    const int aoff = lds_byte(wr * 64 + fr, fq * 8), boff = lds_byte(wc * 32 + fr, fq * 8);
#define PG8_SA(b, h) (((b) * 2 + (h)) * HTB)
#define PG8_SB(b, h) ((4 + (b) * 2 + (h)) * HTB)
#define PG8_STAGE(bufoff, gbase, voff) do { _Pragma("unroll") for (int _i = 0; _i < 2; ++_i) \
        __builtin_amdgcn_global_load_lds((const unsigned*)((const char*)(gbase) + (voff)[_i]), (PG8_LAS unsigned*)(lds + (bufoff) + ldsw + _i * 8192), 16, 0, 0); } while (0)
#define PG8_LDA(dst, b, h) do { _Pragma("unroll") for (int m = 0; m < 4; ++m) _Pragma("unroll") for (int k = 0; k < 2; ++k) dst[m][k] = *(const PG8_LAS bf16x8*)(lds + PG8_SA(b, h) + aoff + m * 2048 + k * 1024); } while (0)
#define PG8_LDB(dst, b, h) do { _Pragma("unroll") for (int n = 0; n < 2; ++n) _Pragma("unroll") for (int k = 0; k < 2; ++k) dst[n][k] = *(const PG8_LAS bf16x8*)(lds + PG8_SB(b, h) + boff + n * 2048 + k * 1024); } while (0)
#define PG8_MMA(ai, bj, At, Bt) do { __builtin_amdgcn_s_setprio(1); _Pragma("unroll") for (int m = 0; m < 4; ++m) _Pragma("unroll") for (int n = 0; n < 2; ++n) _Pragma("unroll") for (int k = 0; k < 2; ++k) \
        acc[ai][bj][m][n] = __builtin_amdgcn_mfma_f32_16x16x32_bf16(Bt[n][k], At[m][k], acc[ai][bj][m][n], 0, 0, 0); __builtin_amdgcn_s_setprio(0); } while (0)
#define PG8_WAIT_V(n) asm volatile("s_waitcnt vmcnt(" #n ")" ::: "memory")
#define PG8_WAIT_L(n) asm volatile("s_waitcnt lgkmcnt(" #n ")" ::: "memory")
#define PG8_BAR __builtin_amdgcn_s_barrier()
#define PG8_SCHED __builtin_amdgcn_sched_barrier(0)
#define PG8_APTR(u) ((const char*)g.A + ((size_t)(u).pm * g.a_pm + (size_t)(u).pn * g.a_pn) * 2)
#define PG8_BPTR(u) ((const char*)g.Bt + ((size_t)(u).pn * g.b_pn + (size_t)((u).pm >> 4) * g.b_pb + (size_t)(u).pm * g.b_pm) * 2)
    Unit cur, nxt; int ui = 0;
    if (!S.next(0, cur)) return;
    f32x4 acc[2][2][4][2];
#pragma unroll
    for (int a = 0; a < 2; ++a)
#pragma unroll
        for (int b = 0; b < 2; ++b)
#pragma unroll
            for (int m = 0; m < 4; ++m)
#pragma unroll
                for (int n = 0; n < 2; ++n) acc[a][b][m][n] = (f32x4){0.f, 0.f, 0.f, 0.f};
    bf16x8 At[4][2], B0[2][2], B1[2][2];
    const char* cA = PG8_APTR(cur); const char* cB = PG8_BPTR(cur);
    PG8_STAGE(PG8_SB(0, 0), cB, voffB); PG8_STAGE(PG8_SB(0, 1), cB + hstepB, voffB); PG8_STAGE(PG8_SA(0, 0), cA, voffA); PG8_STAGE(PG8_SA(0, 1), cA + hstepA, voffA);
    if (wr == 1) PG8_BAR;
    PG8_WAIT_V(2); PG8_BAR;
    PG8_STAGE(PG8_SB(1, 0), cB + kstep, voffB); PG8_STAGE(PG8_SA(1, 0), cA + kstep, voffA); PG8_STAGE(PG8_SB(1, 1), cB + hstepB + kstep, voffB);
    PG8_WAIT_V(6); PG8_BAR;
    for (;;) {
        const bool has_next = S.next(ui + 1, nxt);
        const char* nA = has_next ? PG8_APTR(nxt) : cA; const char* nB = has_next ? PG8_BPTR(nxt) : cB;
#define PG8_TRIP(a1h, pB00, vB00, pB01, vB01, pA00, vA00, pA01, vA01, pB10, vB10, pB11, vB11, pA10, vA10) do { \
            PG8_LDB(B0, 0, 0); PG8_LDB(B1, 0, 1); PG8_SCHED; PG8_LDA(At, 0, 0); PG8_STAGE(PG8_SA(1, 1), a1h, voffA); \
            PG8_WAIT_V(8); PG8_WAIT_L(0); PG8_BAR; PG8_MMA(0, 0, At, B0); PG8_MMA(0, 1, At, B1); PG8_BAR; PG8_SCHED; \
            PG8_LDA(At, 0, 1); PG8_STAGE(PG8_SB(0, 0), pB00, vB00); PG8_STAGE(PG8_SB(0, 1), pB01, vB01); PG8_STAGE(PG8_SA(0, 0), pA00, vA00); \
            PG8_WAIT_V(8); PG8_WAIT_L(0); PG8_BAR; PG8_MMA(1, 0, At, B0); PG8_MMA(1, 1, At, B1); PG8_BAR; PG8_SCHED; \
            PG8_LDB(B0, 1, 0); PG8_LDB(B1, 1, 1); PG8_SCHED; PG8_LDA(At, 1, 0); PG8_STAGE(PG8_SA(0, 1), pA01, vA01); \
            PG8_WAIT_V(8); PG8_WAIT_L(0); PG8_BAR; PG8_MMA(0, 0, At, B0); PG8_MMA(0, 1, At, B1); PG8_BAR; PG8_SCHED; \
            PG8_LDA(At, 1, 1); PG8_STAGE(PG8_SB(1, 0), pB10, vB10); PG8_STAGE(PG8_SB(1, 1), pB11, vB11); PG8_STAGE(PG8_SA(1, 0), pA10, vA10); \
            PG8_WAIT_V(8); PG8_WAIT_L(0); PG8_BAR; PG8_MMA(1, 0, At, B0); PG8_MMA(1, 1, At, B1); PG8_BAR; PG8_SCHED; } while (0)
        const int tend = Epi::RESID_PREFETCH ? nt - 2 : nt;
        for (int t = 0; t < tend; t += 2) {
            const bool last = (t == nt - 2);
            const char* a1 = cA + (size_t)(t + 1) * kstep;
            const char* a2 = last ? nA : cA + (size_t)(t + 2) * kstep; const char* b2 = last ? nB : cB + (size_t)(t + 2) * kstep;
            const char* a3 = a2 + kstep; const char* b3 = b2 + kstep;
            PG8_TRIP(a1 + hstepA, b2, voffB, b2 + hstepB, voffB, a2, voffA, a2 + hstepA, voffA, b3, voffB, b3 + hstepB, voffB, a3, voffA);
        }
        if constexpr (Epi::RESID_PREFETCH) {
            unsigned voffR[2];
#pragma unroll
            for (int i = 0; i < 2; ++i) { int R, C; stage_rc(tid * 16 + i * 8192, R, C); voffR[i] = (unsigned)(R * 1024 + C) * 2u; }
            const char* rb = (const char*)E.xb + ((size_t)cur.pm * BM * 1024 + (size_t)cur.pn * BM) * 2; const size_t rh = (size_t)HALF * 1024 * 2;
            const char* a1 = cA + (size_t)(nt - 1) * kstep;
            PG8_TRIP(a1 + hstepA, rb, voffR, rb + 128, voffR, rb + 256, voffR, rb + 384, voffR, rb + rh, voffR, rb + rh + 128, voffR, rb + rh + 256, voffR);
        }
#undef PG8_TRIP
        if constexpr (ALIGN_EPI) { if (wr == 0) PG8_BAR; }
        if constexpr (!Epi::AFTER_DRAIN) { E(acc, cur, wr, wc, fr, fq, lds + STAGE_BYTES, tid); }
        if (!has_next) break;
#pragma unroll
        for (int a = 0; a < 2; ++a)
#pragma unroll
            for (int b = 0; b < 2; ++b)
#pragma unroll
                for (int m = 0; m < 4; ++m)
#pragma unroll
                    for (int n = 0; n < 2; ++n) acc[a][b][m][n] = (f32x4){0.f, 0.f, 0.f, 0.f};
        cur = nxt; cA = nA; cB = nB; ++ui;
        if constexpr (ALIGN_EPI) { if (wr == 1) PG8_BAR; }
    }
    PG8_WAIT_V(0);
    if constexpr (!ALIGN_EPI) { if (wr == 0) PG8_BAR; }
    PG8_BAR;
    if constexpr (Epi::AFTER_DRAIN) { E.fused(acc, cur, wr, wc, fr, fq, lds, wid, lane); }
#undef PG8_SA
#undef PG8_SB
#undef PG8_STAGE
#undef PG8_LDA
#undef PG8_LDB
#undef PG8_MMA
#undef PG8_WAIT_V
#undef PG8_WAIT_L
#undef PG8_BAR
#undef PG8_SCHED
#undef PG8_APTR
#undef PG8_BPTR
}
}

#ifndef PROBE_MASK
#define PROBE_MASK 0
#endif
#ifndef PROBE_K2
#define PROBE_K2 0
#endif
#ifndef PROBE_EPI
#define PROBE_EPI 0
#endif
namespace mk {
using pg8::bf16_t; using pg8::bf16x8; using pg8::f32x4; using pg8::f32x2; using pg8::u32x4; using pg8::u32x2; using pg8::cvt_pk_bf16;
#define LAS __attribute__((address_space(3)))
constexpr int NWAVES = 8, NTHR = 512;
constexpr int D = 1024, BATCH = 4, SEQ = 4096, M = BATCH * SEQ, DFF = 2816, DZ = 2048, NMEM = 256;
constexpr int LDS_BYTES = 147456, RING_BYTES = 131072;
constexpr size_t MiB = 1u << 20;
constexpr size_t WS_CTL = 0, WS_SS = 1 * MiB, WS_MEMN = 2 * MiB, WS_KB = 6 * MiB, WS_VT = 10 * MiB, WS_W = 14 * MiB, WS_XB = 108 * MiB, WS_R = 140 * MiB, WS_VWO = 236 * MiB, WS_KQ = 244 * MiB, WS_END = 252 * MiB;
constexpr size_t W_LAYER = 47 * MiB;
constexpr size_t W_1IN = 0, W_1OUT = 11 * MiB, W_MIXIN = 16 * MiB + MiB / 2, W_MIXOUT = 20 * MiB + MiB / 2, W_Q = 22 * MiB + MiB / 2, W_KV = 24 * MiB + MiB / 2, W_O = 28 * MiB + MiB / 2,
                 W_2IN = 30 * MiB + MiB / 2, W_2OUT = 41 * MiB + MiB / 2;
constexpr int LDR = pg8::LDR, ZS = LDR, YS = LDR;
constexpr int CW_G2 = 12288;
constexpr int NPH = 24;
constexpr float QSCALE = 1.4426950408889634f / 16.0f;

struct Args { const float* in[26]; float* out; unsigned char* ws; int ph_lo, ph_hi; };

__device__ __forceinline__ float wave_sum(float v) {
#pragma unroll
    for (int o = 1; o < 64; o <<= 1) v += __shfl_xor(v, o);
    return v;
}
__device__ __forceinline__ float bf_lo(unsigned u) { return __uint_as_float(u << 16); }
__device__ __forceinline__ float bf_hi(unsigned u) { return __uint_as_float(u & 0xffff0000u); }
#define LDS_WAIT() asm volatile("s_waitcnt lgkmcnt(0)" ::: "memory")


#define XB_TMO      128
#define XB_XCNT(j)  (256  + 64 * (j))
#define XB_XSUB(j)  (1280 + 64 * (j))
#define XB_XGEN(j)  (2304 + 64 * (j))
#define XB_TOP      3328
#define XB_TOPGEN   3392
#define XCD_BAR_WORDS 3456
#define XB_SPIN_CAP (1u << 20)
__device__ __forceinline__ unsigned xb_ld(unsigned* p)              { return __hip_atomic_load(p, __ATOMIC_RELAXED, __HIP_MEMORY_SCOPE_AGENT); }
__device__ __forceinline__ unsigned xb_add(unsigned* p, unsigned v) { return __hip_atomic_fetch_add(p, v, __ATOMIC_RELAXED, __HIP_MEMORY_SCOPE_AGENT); }
__device__ __forceinline__ unsigned xb_xcc_id() { return (unsigned)__builtin_amdgcn_s_getreg((3 << 11) | 20) & 0xFu; }
#define XB_SPIN(cond, bar) do { unsigned _sp = 0; while (cond) { __builtin_amdgcn_s_sleep(1); \
    if ((++_sp & 255u) == 0u) { if (xb_ld(&(bar)[XB_TMO])) break; if (_sp > XB_SPIN_CAP) { atomicAdd(&(bar)[XB_TMO], 1u); break; } } } } while (0)
struct XcdBarrier { unsigned* bar; unsigned x; volatile LAS unsigned* st; };
__device__ __forceinline__ XcdBarrier xcd_barrier_post(unsigned* bar, volatile LAS unsigned* st) {
    XcdBarrier b; b.bar = bar; b.x = xb_xcc_id(); b.st = st;
    if (threadIdx.x == 0) st[3] = xb_add(&bar[XB_XCNT(b.x)], 1u);
    return b;
}
__device__ __forceinline__ void xcd_barrier_complete(unsigned* bar, unsigned x, unsigned& nloc, unsigned& nx, unsigned& uni) {
    const unsigned G = gridDim.x * gridDim.y * gridDim.z;
    unsigned sum, cnt, mine, sp = 0u, u32 = 0u;
    for (;;) {
        sum = 0u; cnt = 0u; mine = 0u; u32 = 1u;
#pragma unroll
        for (unsigned j = 0; j < 16; ++j) { const unsigned c = xb_ld(&bar[XB_XCNT(j)]); sum += c; cnt += (c > 0u) ? 1u : 0u; mine = (j == x) ? c : mine; u32 &= (c == (j < 8u ? 32u : 0u)) ? 1u : 0u; }
        if (sum == G) break;
        __builtin_amdgcn_s_sleep(1);
        if ((++sp & 255u) == 0u) { if (xb_ld(&bar[XB_TMO])) break; if (sp > XB_SPIN_CAP) { atomicAdd(&bar[XB_TMO], 1u); break; } }
    }
    nloc = mine > 0u ? mine : 1u; nx = cnt > 0u ? cnt : 1u; uni = (sum == G && G == 256u) ? u32 : 0u;
}
__device__ __forceinline__ void xcd_barrier(const XcdBarrier& b, bool flush = true, bool local = false) {
    asm volatile("s_waitcnt vmcnt(0)" ::: "memory");
    __syncthreads();
    if (threadIdx.x == 0) {
        unsigned* bar = b.bar;
        __builtin_amdgcn_s_waitcnt(0);
        unsigned nloc = b.st[0], nx = b.st[1];
        if (nloc == 0u) { unsigned uni; xcd_barrier_complete(bar, b.x, nloc, nx, uni); b.st[0] = nloc; b.st[1] = nx; b.st[2] = uni; }
        const unsigned old = xb_add(&bar[XB_XSUB(b.x)], 1u);
        const unsigned gen = old / nloc;
        if (old + 1u == (gen + 1u) * nloc) {
            if (flush) { __builtin_amdgcn_fence(__ATOMIC_RELEASE, "agent");
            asm volatile("s_waitcnt vmcnt(0)" ::: "memory"); }
            if (!local) {
            const unsigned og = xb_add(&bar[XB_TOP], 1u);
            const unsigned tg = og / nx;
            if (og + 1u == (tg + 1u) * nx) xb_add(&bar[XB_TOPGEN], 1u);
            else XB_SPIN(xb_ld(&bar[XB_TOPGEN]) == tg, bar);
            }
            __builtin_amdgcn_fence(__ATOMIC_ACQUIRE, "agent");
            xb_add(&bar[XB_XGEN(b.x)], 1u);
            asm volatile("s_waitcnt vmcnt(0)" ::: "memory");
        } else {
            XB_SPIN(xb_ld(&bar[XB_XGEN(b.x)]) == gen, bar);
            __builtin_amdgcn_fence(__ATOMIC_ACQUIRE, "agent");
            asm volatile("s_waitcnt vmcnt(0)" ::: "memory");
        }
    }
    __syncthreads();
}

__device__ __forceinline__ void group_barrier(unsigned* gc) {
    asm volatile("s_waitcnt vmcnt(0)" ::: "memory");
    __syncthreads();
    if (threadIdx.x == 0) {
        __builtin_amdgcn_s_waitcnt(0);
        const unsigned old = xb_add(gc, 1u), target = (old / 4u + 1u) * 4u;
        unsigned sp = 0u;
        while (xb_ld(gc) < target) { __builtin_amdgcn_s_sleep(1); if (++sp > (XB_SPIN_CAP << 4)) break; }
        __builtin_amdgcn_fence(__ATOMIC_ACQUIRE, "agent");
        asm volatile("s_waitcnt vmcnt(0)" ::: "memory");
    }
    __syncthreads();
}

struct EpiFinal {
    static constexpr bool PERM = true, AFTER_DRAIN = true, RESID_PREFETCH = false;
    const bf16_t* xb; float* ss; const float* gfin; float* out; float alpha; XcdBarrier bar; bool flush; unsigned* gc;
    __device__ __forceinline__ void fused(f32x4 (&acc)[2][2][4][2], const pg8::Unit& u, int wr, int wc, int fr, int fq, LAS unsigned char* lds, int wid, int lane) const {
        LAS float* Pq = (LAS float*)lds;
        const int tid = wid * 64 + lane;
        const int row0 = u.pm * 256 + wr * 64 + fr, col0 = u.pn * 256 + wc * 32 + 8 * fq;
#pragma unroll
        for (int ai = 0; ai < 2; ++ai)
#pragma unroll
            for (int m = 0; m < 4; ++m) { const int row = row0 + ai * 128 + m * 16; const bf16_t* rowp = xb + (size_t)row * 1024 + col0; float q = 0.f;
#pragma unroll
                for (int bj = 0; bj < 2; ++bj) { const u32x4 b = *(const u32x4*)(rowp + bj * 128);
                    const f32x4 o0 = (f32x4){bf_lo(b.x), bf_hi(b.x), bf_lo(b.y), bf_hi(b.y)} + acc[ai][bj][m][0] * alpha;
                    const f32x4 o1 = (f32x4){bf_lo(b.z), bf_hi(b.z), bf_lo(b.w), bf_hi(b.w)} + acc[ai][bj][m][1] * alpha;
                    acc[ai][bj][m][0] = o0; acc[ai][bj][m][1] = o1;
                    q += ((o0[0] * o0[0] + o0[1] * o0[1]) + (o0[2] * o0[2] + o0[3] * o0[3])) + ((o1[0] * o1[0] + o1[1] * o1[1]) + (o1[2] * o1[2] + o1[3] * o1[3])); }
                q += __shfl_xor(q, 16); q += __shfl_xor(q, 32);
                if (fq == 0) Pq[(ai * 128 + wr * 64 + m * 16 + fr) * 4 + wc] = q; }
        __syncthreads();
        if (tid < 256) { const f32x4 v = *(const LAS f32x4*)(Pq + tid * 4); ss[(size_t)(u.pm * 256 + tid) * 4 + u.pn] = (v[0] + v[1]) + (v[2] + v[3]); }
        if (gc) group_barrier(gc); else xcd_barrier(bar, flush, !flush);
#pragma unroll
        for (int ai = 0; ai < 2; ++ai) {
            if (ai) __syncthreads();
#pragma unroll
            for (int m = 0; m < 4; ++m) { const int rl = wr * 64 + m * 16 + fr; const float rs = pg8::row_rs(ss, u.pm * 256 + ai * 128 + rl);
#pragma unroll
                for (int bj = 0; bj < 2; ++bj)
#pragma unroll
                    for (int n = 0; n < 2; ++n) { const int chunk = bj * 32 + wc * 8 + 2 * fq + n; const f32x4 g = *(const f32x4*)(gfin + u.pn * 256 + 4 * chunk);
                        *(LAS f32x4*)(lds + rl * 1024 + ((chunk ^ fr) * 16)) = acc[ai][bj][m][n] * rs * g; } }
            __syncthreads();
#pragma unroll 4
            for (int j = 0; j < 16; ++j) { const int rl = wid * 16 + j; const f32x4 v = *(const LAS f32x4*)(lds + rl * 1024 + ((lane ^ (rl & 15)) * 16));
                *(f32x4*)(out + (size_t)(u.pm * 256 + ai * 128 + rl) * 1024 + u.pn * 256 + 4 * lane) = v; }
        }
    }
};

__device__ __forceinline__ void p0_transpose_item(const float* W, int K, int N, bf16_t* WT, int dst_row0, const float* gk, LAS float* scr, int k0, int n0, int lane, bool wt = false) {
    f32x4 v[16];
#pragma unroll
    for (int i = 0; i < 16; ++i) { const int kk = 4 * i + (lane >> 4); v[i] = *(const f32x4*)(W + (size_t)(k0 + kk) * N + n0 + 4 * (lane & 15)); }
    if (gk) {
#pragma unroll
        for (int i = 0; i < 16; ++i) { const int kk = 4 * i + (lane >> 4); v[i] = v[i] * gk[k0 + kk]; }
    }
#pragma unroll
    for (int i = 0; i < 16; ++i) { const int kk = 4 * i + (lane >> 4); *(LAS f32x4*)(scr + kk * 68 + ((4 * (lane & 15)) ^ (4 * ((kk >> 3) & 7)))) = v[i]; }
    LDS_WAIT(); asm volatile("" ::: "memory");
    const int c = lane & 7, nl = lane >> 3;
#pragma unroll
    for (int j = 0; j < 8; ++j) { const int n = nl + 8 * j; const LAS float* sp = scr + (8 * c) * 68 + (n ^ (4 * c));
        u32x4 o; o.x = cvt_pk_bf16(sp[0 * 68], sp[1 * 68]); o.y = cvt_pk_bf16(sp[2 * 68], sp[3 * 68]); o.z = cvt_pk_bf16(sp[4 * 68], sp[5 * 68]); o.w = cvt_pk_bf16(sp[6 * 68], sp[7 * 68]);
        bf16_t* dp = WT + (size_t)(dst_row0 + n) * K + k0 + 8 * c;
        if (wt) asm volatile("global_store_dwordx4 %0, %1, off sc1\n\ts_nop 1" :: "v"(dp), "v"(o) : "memory"); else *(u32x4*)dp = o; }
    LDS_WAIT(); asm volatile("" ::: "memory");
}
__device__ __forceinline__ void p0_convert_item(const float* W, int N, bf16_t* Wb, const float* gk, int k0, int n0, int lane) {
    f32x4 v[16];
#pragma unroll
    for (int i = 0; i < 16; ++i) { const int kk = 4 * i + (lane >> 4); v[i] = *(const f32x4*)(W + (size_t)(k0 + kk) * N + n0 + 4 * (lane & 15)); }
#pragma unroll
    for (int i = 0; i < 16; ++i) { const int kk = 4 * i + (lane >> 4); const f32x4 y = v[i] * gk[k0 + kk];
        u32x2 o; o.x = cvt_pk_bf16(y[0], y[1]); o.y = cvt_pk_bf16(y[2], y[3]); *(u32x2*)(Wb + (size_t)(k0 + kk) * N + n0 + 4 * (lane & 15)) = o; }
}
template <bool SWIGLU>
__device__ __forceinline__ bool p0_matrix(int& r, const float* W, int K, int N, bf16_t* WT, const float* gk, LAS float* scr, int lane, bool wt = false) {
    const int nblk = N / 64, items = (K / 64) * nblk;
    if (r >= items) { r -= items; return false; }
    const int kb = r / nblk, nb = r % nblk, n0 = 64 * nb; int dst0 = n0;
    if (SWIGLU) { const int bj = n0 >= DFF ? 1 : 0, j = n0 - bj * DFF; dst0 = 256 * (j >> 7) + 128 * bj + (j & 127); }
    p0_transpose_item(W, K, N, WT, dst0, gk, scr, 64 * kb, n0, lane, wt);
    return true;
}
template <int MAT>
__device__ __forceinline__ bool conv_mat(int& r, const Args& a, int l, LAS float* scr, int lane, bool wt = false) {
    unsigned char* wl = a.ws + WS_W + (size_t)l * W_LAYER;
    if (MAT == 0) return p0_matrix<true>(r, a.in[3] + (size_t)l * D * 2 * DFF, D, 2 * DFF, (bf16_t*)(wl + W_1IN), a.in[2] + l * D, scr, lane, wt);
    if (MAT == 1) return p0_matrix<false>(r, a.in[4] + (size_t)l * DFF * D, DFF, D, (bf16_t*)(wl + W_1OUT), nullptr, scr, lane, wt);
    if (MAT == 2) return p0_matrix<false>(r, a.in[6] + (size_t)l * D * DZ, D, DZ, (bf16_t*)(wl + W_MIXIN), a.in[5] + l * D, scr, lane, wt);
    if (MAT == 3) return p0_matrix<false>(r, a.in[16] + (size_t)l * D * D, D, D, (bf16_t*)(wl + W_MIXOUT), nullptr, scr, lane);
    if (MAT == 4) { if (r >= 256) { r -= 256; return false; } p0_convert_item(a.in[19] + (size_t)l * D * D, D, (bf16_t*)(wl + W_Q), a.in[17] + l * D, 64 * (r / 16), 64 * (r % 16), lane); return true; }
    if (MAT == 5) return p0_matrix<false>(r, a.in[20] + (size_t)l * D * 2 * D, D, 2 * D, (bf16_t*)(wl + W_KV), nullptr, scr, lane);
    if (MAT == 6) return p0_matrix<false>(r, a.in[21] + (size_t)l * D * D, D, D, (bf16_t*)(wl + W_O), nullptr, scr, lane);
    if (MAT == 7) return p0_matrix<true>(r, a.in[23] + (size_t)l * D * 2 * DFF, D, 2 * DFF, (bf16_t*)(wl + W_2IN), a.in[22] + l * D, scr, lane);
    return p0_matrix<false>(r, a.in[24] + (size_t)l * DFF * D, DFF, D, (bf16_t*)(wl + W_2OUT), nullptr, scr, lane, wt);
}
template <int GROUP>
__device__ __forceinline__ void convert_group(const Args& a, LAS unsigned char* lds, int gwx, int ngwx, int wave, int lane_in) {
    int lane = lane_in; asm volatile("" : "+v"(lane));
    LAS float* scr = (LAS float*)(lds + wave * 17408);
    constexpr int TOTAL = GROUP == 0 ? 1408 + 512 + 704 + 512 : GROUP == 1 ? 256 + 256 + 256 + 1408 + 512 : GROUP == 2 ? 704 + 1408 + 704 + 512 + 256 + 256 + 256 : 1408 + 704;
    for (int it = gwx; it < TOTAL; it += ngwx) {
        int r = it;
        if (GROUP == 0) { if (conv_mat<0>(r, a, 0, scr, lane)) continue; if (conv_mat<5>(r, a, 0, scr, lane)) continue; if (conv_mat<1>(r, a, 0, scr, lane)) continue; conv_mat<2>(r, a, 0, scr, lane); }
        if (GROUP == 1) { if (conv_mat<3>(r, a, 0, scr, lane)) continue; if (conv_mat<4>(r, a, 0, scr, lane)) continue;
                          if (conv_mat<6>(r, a, 0, scr, lane)) continue; if (conv_mat<7>(r, a, 0, scr, lane)) continue; conv_mat<5>(r, a, 1, scr, lane); }
        if (GROUP == 2) { if (conv_mat<8>(r, a, 0, scr, lane, true)) continue; if (conv_mat<0>(r, a, 1, scr, lane, true)) continue; if (conv_mat<1>(r, a, 1, scr, lane, true)) continue; if (conv_mat<2>(r, a, 1, scr, lane, true)) continue;
                          if (conv_mat<3>(r, a, 1, scr, lane)) continue; if (conv_mat<4>(r, a, 1, scr, lane)) continue; conv_mat<6>(r, a, 1, scr, lane); }
        if (GROUP == 3) { if (conv_mat<7>(r, a, 1, scr, lane)) continue; conv_mat<8>(r, a, 1, scr, lane); }
    }
}
__device__ __forceinline__ void p0_prologue(const Args& a, LAS unsigned char* lds, int gw, int NGW, int wave, int lane) {
    unsigned char* ws = a.ws;
    convert_group<0>(a, lds, gw, NGW, wave, lane);
    bf16_t* XB = (bf16_t*)(ws + WS_XB); float* SS = (float*)(ws + WS_SS);
    for (int m = gw; m < M; m += NGW) {
        const f32x4* xr = (const f32x4*)(a.in[0] + (size_t)m * D) + lane; float s = 0.f;
        unsigned long long* o8 = (unsigned long long*)(XB + (size_t)m * D) + lane;
#pragma unroll
        for (int j = 0; j < 4; ++j) { const f32x4 v = xr[64 * j]; s += (v[0] * v[0] + v[1] * v[1]) + (v[2] * v[2] + v[3] * v[3]);
            o8[64 * j] = (unsigned long long)cvt_pk_bf16(v[0], v[1]) | ((unsigned long long)cvt_pk_bf16(v[2], v[3]) << 32); }
        s = wave_sum(s);
        if (lane < 4) SS[(size_t)m * 4 + lane] = lane == 0 ? s : 0.f;
    }
    for (int m = gw; m < 2 * BATCH * NMEM; m += NGW) {
        const int l = m / (BATCH * NMEM), rr = m % (BATCH * NMEM);
        const f32x4* xr = (const f32x4*)(a.in[1] + (size_t)rr * D) + lane; const f32x4* gr = (const f32x4*)(a.in[18] + l * D) + lane; f32x4 v[4]; float s = 0.f;
#pragma unroll
        for (int j = 0; j < 4; ++j) { v[j] = xr[64 * j]; s += (v[j][0] * v[j][0] + v[j][1] * v[j][1]) + (v[j][2] * v[j][2] + v[j][3] * v[j][3]); }
        const float rs = 1.0f / sqrtf(wave_sum(s) * (1.0f / D) + 1e-6f);
        unsigned long long* o8 = (unsigned long long*)((bf16_t*)(ws + WS_MEMN) + (size_t)m * D) + lane;
#pragma unroll
        for (int j = 0; j < 4; ++j) { const f32x4 g = gr[64 * j]; const f32x4 y = v[j] * rs * g;
            o8[64 * j] = (unsigned long long)cvt_pk_bf16(y[0], y[1]) | ((unsigned long long)cvt_pk_bf16(y[2], y[3]) << 32); }
    }
}

__device__ __forceinline__ f32x4 bf4_lo(const u32x4 u) { return (f32x4){bf_lo(u.x), bf_hi(u.x), bf_lo(u.y), bf_hi(u.y)}; }
__device__ __forceinline__ f32x4 bf4_hi(const u32x4 u) { return (f32x4){bf_lo(u.z), bf_hi(u.z), bf_lo(u.w), bf_hi(u.w)}; }
__device__ __forceinline__ void mixer_a(const bf16_t* Z, bf16_t* Y, const float* sw, int ch, int tid) {
    const int m0 = ch * 128, t0 = m0 & (SEQ - 1);
    const int cg8 = tid & 31, c = 8 * cg8;
    const f32x4 w0l = *(const f32x4*)(sw + c), w0h = *(const f32x4*)(sw + c + 4), w1l = *(const f32x4*)(sw + 256 + c), w1h = *(const f32x4*)(sw + 256 + c + 4), w2l = *(const f32x4*)(sw + 512 + c), w2h = *(const f32x4*)(sw + 512 + c + 4);
#pragma unroll 4
    for (int it = 0; it < 8; ++it) {
        const int tl = (tid >> 5) + 16 * it, tpos = t0 + tl; const bf16_t* zr = Z + (size_t)(m0 + tl) * ZS + c;
        const u32x4 zero = (u32x4){0u, 0u, 0u, 0u};
        const u32x4 ub = *(const u32x4*)zr, uc0 = *(const u32x4*)(zr + 256), ux0 = *(const u32x4*)(zr + 512);
        u32x4 uc1 = *(const u32x4*)(zr - ZS + 256), ux1 = *(const u32x4*)(zr - ZS + 512);
        u32x4 uc2 = *(const u32x4*)(zr - 2 * ZS + 256), ux2 = *(const u32x4*)(zr - 2 * ZS + 512);
        if (tpos < 1) uc1 = zero; if (tpos < 2) uc2 = zero;
        const f32x4 yl = bf4_lo(ub) * (w0l * (bf4_lo(uc2) * bf4_lo(ux2)) + w1l * (bf4_lo(uc1) * bf4_lo(ux1)) + w2l * (bf4_lo(uc0) * bf4_lo(ux0)));
        const f32x4 yh = bf4_hi(ub) * (w0h * (bf4_hi(uc2) * bf4_hi(ux2)) + w1h * (bf4_hi(uc1) * bf4_hi(ux1)) + w2h * (bf4_hi(uc0) * bf4_hi(ux0)));
        u32x4 o; o.x = cvt_pk_bf16(yl[0], yl[1]); o.y = cvt_pk_bf16(yl[2], yl[3]); o.z = cvt_pk_bf16(yh[0], yh[1]); o.w = cvt_pk_bf16(yh[2], yh[3]);
        *(u32x4*)(Y + (size_t)(m0 + tl) * YS + c) = o;
    }
}
__device__ __forceinline__ void mixer_d(const bf16_t* Z, bf16_t* Y, const float* pw, const float* pscale, LAS unsigned char* lds, int hd, int tid) {
    constexpr int PS = 264;
    LAS bf16_t* WT = (LAS bf16_t*)lds;
    LAS bf16_t* PL = (LAS bf16_t*)(lds + 40960);
    const int m0 = hd * 64, t0 = m0 & (SEQ - 1);
    u32x4 wfr[2][4]; f32x4 scv[4];
    { const int lane = tid & 63, fr = lane & 15, fq = lane >> 4, g = (tid >> 6) >> 1;
#pragma unroll
      for (int ks = 0; ks < 2; ++ks)
#pragma unroll
        for (int nt = 0; nt < 4; ++nt) { const float* wp = pw + ((size_t)g * 64 + 32 * ks + 8 * fq) * 64 + 16 * nt + fr;
            wfr[ks][nt].x = cvt_pk_bf16(wp[0], wp[64]); wfr[ks][nt].y = cvt_pk_bf16(wp[128], wp[192]); wfr[ks][nt].z = cvt_pk_bf16(wp[256], wp[320]); wfr[ks][nt].w = cvt_pk_bf16(wp[384], wp[448]); }
#pragma unroll
      for (int nt = 0; nt < 4; ++nt) scv[nt] = *(const f32x4*)(pscale + g * 64 + 16 * nt + 4 * fq); }
#pragma unroll
    for (int it = 0; it < 5; ++it) { const int idx = tid + NTHR * it; const int r = idx >> 5, cg8 = idx & 31;
            u32x4 v = *(const u32x4*)(Z + (size_t)(m0 - 15 + r) * ZS + 1792 + 8 * cg8); if (t0 - 15 + r < 0) v = (u32x4){0u, 0u, 0u, 0u};
            *(LAS u32x4*)(WT + r * 256 + 8 * cg8) = v; }
    __syncthreads();
    {
        const int cp = tid & 127, tg = tid >> 7, c = 2 * cp, k = 2 << (c >> 6);
        const int r0 = 15 + 16 * tg, tpos = t0 + 16 * tg;
        float sa = 0.f, sb = 0.f;
        for (int j = 1; j < k; ++j) { const unsigned u = *(const LAS unsigned*)(WT + (r0 - j) * 256 + c); sa += bf_lo(u); sb += bf_hi(u); }
#pragma unroll 4
        for (int i = 0; i < 16; ++i) {
            const unsigned u = *(const LAS unsigned*)(WT + (r0 + i) * 256 + c); const float wa = bf_lo(u), wb = bf_hi(u);
            sa += wa; sb += wb;
            const int cnt = (tpos + i + 1 < k) ? (tpos + i + 1) : k; const float inv = 1.0f / (float)cnt;
            *(LAS unsigned*)(PL + (16 * tg + i) * PS + c) = cvt_pk_bf16(sa * inv - wa, sb * inv - wb);
            const unsigned u2 = *(const LAS unsigned*)(WT + (r0 + i - (k - 1)) * 256 + c); sa -= bf_lo(u2); sb -= bf_hi(u2);
        }
    }
    __syncthreads();
    {
        const int wave = tid >> 6, lane = tid & 63, fr = lane & 15, fq = lane >> 4, g = wave >> 1, th = wave & 1;
        f32x4 acc[2][4];
#pragma unroll
        for (int mt = 0; mt < 2; ++mt)
#pragma unroll
            for (int nt = 0; nt < 4; ++nt) acc[mt][nt] = (f32x4){0.f, 0.f, 0.f, 0.f};
#pragma unroll
        for (int ks = 0; ks < 2; ++ks) {
            bf16x8 pf[2];
#pragma unroll
            for (int mt = 0; mt < 2; ++mt) pf[mt] = *(const LAS bf16x8*)(PL + (32 * th + 16 * mt + fr) * PS + g * 64 + 32 * ks + 8 * fq);
#pragma unroll
            for (int nt = 0; nt < 4; ++nt) { const bf16x8 wf = __builtin_bit_cast(bf16x8, wfr[ks][nt]);
#pragma unroll
                for (int mt = 0; mt < 2; ++mt) acc[mt][nt] = __builtin_amdgcn_mfma_f32_16x16x32_bf16(wf, pf[mt], acc[mt][nt], 0, 0, 0); }
        }
#pragma unroll
        for (int nt = 0; nt < 4; ++nt) { const int d0 = g * 64 + 16 * nt + 4 * fq; const f32x4 sc = scv[nt];
#pragma unroll
            for (int mt = 0; mt < 2; ++mt) { const int t = 32 * th + 16 * mt + fr; const f32x4 y = acc[mt][nt] * sc;
                u32x2 o; o.x = cvt_pk_bf16(y[0], y[1]); o.y = cvt_pk_bf16(y[2], y[3]);
                *(u32x2*)(Y + (size_t)(m0 + t) * YS + 768 + d0) = o; } }
    }
    __syncthreads();
}
__device__ __forceinline__ void mixer_c(const bf16_t* Z, bf16_t* Y, const float* cw, const float* lng, const float* lnb, LAS unsigned char* lds, int hc, int tid) {
    LAS float* GL = (LAS float*)lds;
    const int m0 = hc * 64, t0 = m0 & (SEQ - 1);
    const int c = tid & 255;
    float w[31];
#pragma unroll
    for (int k = 0; k < 31; ++k) w[k] = cw[k * 256 + c];
    const f32x4 g4 = *(const f32x4*)(lng + 4 * (tid & 63)), b4 = *(const f32x4*)(lnb + 4 * (tid & 63));
#pragma unroll
    for (int it = 0; it < 6; ++it) { const int idx = tid + NTHR * it; const int r = idx >> 5, cg8 = idx & 31;
            const bf16_t* zr = Z + (size_t)(m0 - 30 + r) * ZS + 8 * cg8; const u32x4 ua = *(const u32x4*)(zr + 1280), ug = *(const u32x4*)(zr + 1536);
            const f32x4 al = bf4_lo(ua), ah = bf4_hi(ua), sl = bf4_lo(ug), sh = bf4_hi(ug); f32x4 gl, gh;
#pragma unroll
            for (int e = 0; e < 4; ++e) { gl[e] = al[e] * __builtin_amdgcn_rcpf(1.0f + __expf(-sl[e])); gh[e] = ah[e] * __builtin_amdgcn_rcpf(1.0f + __expf(-sh[e])); }
            if (t0 - 30 + r < 0) { gl = (f32x4){0.f, 0.f, 0.f, 0.f}; gh = gl; }
            *(LAS f32x4*)(GL + r * 256 + 8 * cg8) = gl; *(LAS f32x4*)(GL + r * 256 + 8 * cg8 + 4) = gh; }
    __syncthreads();
    float outv[2][16];
    {
#pragma unroll
        for (int it = 0; it < 2; ++it) { const int tg = (tid >> 8) + 2 * it; float gv[46];
#pragma unroll
            for (int j = 0; j < 46; ++j) gv[j] = GL[(16 * tg + j) * 256 + c];
#pragma unroll
            for (int j = 0; j < 16; ++j) { float acc = 0.f;
#pragma unroll
                for (int k = 0; k < 31; ++k) acc += w[k] * gv[j + k];
                outv[it][j] = acc; } }
    }
    __syncthreads();
#pragma unroll
    for (int it = 0; it < 2; ++it) { const int tg = (tid >> 8) + 2 * it;
#pragma unroll
        for (int j = 0; j < 16; ++j) GL[(16 * tg + j) * 256 + c] = outv[it][j]; }
    __syncthreads();
    {
        const int wave = tid >> 6, lane = tid & 63;
#pragma unroll
        for (int i = 0; i < 8; ++i) { const int tt = wave * 8 + i; f32x4 v = *(const LAS f32x4*)(GL + tt * 256 + 4 * lane);
            const float mu = wave_sum((v[0] + v[1]) + (v[2] + v[3])) * (1.0f / 256.0f); v = v - mu;
            const float var = wave_sum((v[0] * v[0] + v[1] * v[1]) + (v[2] * v[2] + v[3] * v[3])) * (1.0f / 256.0f);
            const float rs = 1.0f / sqrtf(var + 1e-6f); f32x4 y = v * rs * g4 + b4;
            y[0] = pg8::fast_silu(y[0]); y[1] = pg8::fast_silu(y[1]); y[2] = pg8::fast_silu(y[2]); y[3] = pg8::fast_silu(y[3]);
            u32x2 o; o.x = cvt_pk_bf16(y[0], y[1]); o.y = cvt_pk_bf16(y[2], y[3]);
            *(u32x2*)(Y + (size_t)(m0 + tt) * YS + 512 + 4 * lane) = o; }
    }
    __syncthreads();
}
__device__ __forceinline__ void mixer_b(const bf16_t* Z, bf16_t* Y, const float* ng, const float* wsg, const float* bs, LAS unsigned char* lds, int ch, int tid) {
    constexpr int VS = 136;
    LAS bf16_t* VT = (LAS bf16_t*)lds;
    const int m0 = ch * 128, wave = tid >> 6, lane = tid & 63, fr = lane & 15, fq = lane >> 4;
    {
        const f32x4 g4 = *(const f32x4*)(ng + 4 * lane);
        unsigned pk[4][8];
#pragma unroll
        for (int j2 = 0; j2 < 8; ++j2) { float y[2][4];
#pragma unroll
            for (int e = 0; e < 2; ++e) { const int s = 16 * wave + 2 * j2 + e; const u32x2 u = *(const u32x2*)(Z + (size_t)(m0 + s) * ZS + 1024 + 4 * lane);
                f32x4 v = (f32x4){bf_lo(u.x), bf_hi(u.x), bf_lo(u.y), bf_hi(u.y)};
                const float mu = wave_sum((v[0] + v[1]) + (v[2] + v[3])) * (1.0f / 256.0f); v = v - mu;
                const float var = wave_sum((v[0] * v[0] + v[1] * v[1]) + (v[2] * v[2] + v[3] * v[3])) * (1.0f / 256.0f);
                const float rs = 1.0f / sqrtf(var + 1e-6f); const f32x4 o = v * rs * g4;
                y[e][0] = o[0]; y[e][1] = o[1]; y[e][2] = o[2]; y[e][3] = o[3]; }
#pragma unroll
            for (int i = 0; i < 4; ++i) pk[i][j2] = cvt_pk_bf16(y[0][i], y[1][i]); }
#pragma unroll
        for (int i = 0; i < 4; ++i) { LAS u32x4* dst = (LAS u32x4*)(VT + (4 * lane + i) * VS + 16 * wave);
            dst[0] = (u32x4){pk[i][0], pk[i][1], pk[i][2], pk[i][3]}; dst[1] = (u32x4){pk[i][4], pk[i][5], pk[i][6], pk[i][7]}; }
    }
    u32x2 ug[4][4]; float biasv[4];
    { const int h = wave >> 1, th = wave & 1;
#pragma unroll
      for (int mt = 0; mt < 4; ++mt) { const int t = 64 * th + 16 * mt + fr; biasv[mt] = bs[h * 128 + t];
#pragma unroll
        for (int nt = 0; nt < 4; ++nt) ug[mt][nt] = *(const u32x2*)(Z + (size_t)(m0 + t) * ZS + 768 + h * 64 + 16 * nt + 4 * fq); } }
    __syncthreads();
    {
        const int h = wave >> 1, th = wave & 1;
        f32x4 acc[4][4];
#pragma unroll
        for (int mt = 0; mt < 4; ++mt)
#pragma unroll
            for (int nt = 0; nt < 4; ++nt) acc[mt][nt] = (f32x4){0.f, 0.f, 0.f, 0.f};
#pragma unroll
        for (int ks = 0; ks < 4; ++ks) {
            if (32 * ks > 64 * th + 63) continue;
            bf16x8 bfr[4];
#pragma unroll
            for (int nt = 0; nt < 4; ++nt) bfr[nt] = *(const LAS bf16x8*)(VT + (h * 64 + 16 * nt + fr) * VS + 32 * ks + 8 * fq);
#pragma unroll
            for (int mt = 0; mt < 4; ++mt) { const int t = 64 * th + 16 * mt + fr, s = 32 * ks + 8 * fq;
                const f32x4* wp = (const f32x4*)(wsg + ((size_t)h * 128 + t) * 128 + s); f32x4 w0 = wp[0], w1 = wp[1];
#pragma unroll
                for (int e = 0; e < 4; ++e) { if (s + e > t) w0[e] = 0.f; if (s + 4 + e > t) w1[e] = 0.f; }
                u32x4 au; au.x = cvt_pk_bf16(w0[0], w0[1]); au.y = cvt_pk_bf16(w0[2], w0[3]); au.z = cvt_pk_bf16(w1[0], w1[1]); au.w = cvt_pk_bf16(w1[2], w1[3]);
                const bf16x8 afr = __builtin_bit_cast(bf16x8, au);
#pragma unroll
                for (int nt = 0; nt < 4; ++nt) acc[mt][nt] = __builtin_amdgcn_mfma_f32_16x16x32_bf16(bfr[nt], afr, acc[mt][nt], 0, 0, 0); }
        }
#pragma unroll
        for (int mt = 0; mt < 4; ++mt) { const int t = 64 * th + 16 * mt + fr; const float bias = biasv[mt];
#pragma unroll
            for (int nt = 0; nt < 4; ++nt) { const int d0 = h * 64 + 16 * nt + 4 * fq; const u32x2 u = ug[mt][nt];
                const f32x4 a = acc[mt][nt]; u32x2 o; o.x = cvt_pk_bf16(bf_lo(u.x) * (a[0] + bias), bf_hi(u.x) * (a[1] + bias)); o.y = cvt_pk_bf16(bf_lo(u.y) * (a[2] + bias), bf_hi(u.y) * (a[3] + bias));
                *(u32x2*)(Y + (size_t)(m0 + t) * YS + 256 + d0) = o; } }
    }
    __syncthreads();
}

template <class Sched>
__device__ __forceinline__ int build_rs_table(const float* ss, const Sched& S, LAS unsigned char* lds, int tid_in) {
    int tid = tid_in; asm volatile("" : "+v"(tid));
    pg8::Unit u0; int pm = -1;
    if (S.next(0, u0)) { pm = u0.pm; if (tid < 256) ((LAS float*)(lds + RING_BYTES + 4096))[tid] = pg8::row_rs(ss, pm * 256 + tid); }
    __syncthreads();
    return pm;
}
__device__ __forceinline__ void kv_gemm(LAS unsigned char* lds, unsigned char* ws, int ll, int G, int c2) {
    const bf16_t* memn = (const bf16_t*)(ws + WS_MEMN) + (size_t)ll * 1024 * D; const bf16_t* wkv = (const bf16_t*)(ws + WS_W + (size_t)ll * W_LAYER + W_KV);
    pg8::StaticOrder S; S.init(1024, 2048, G, c2);
    pg8::Gemm g = pg8::plain_gemm(memn, wkv, D); pg8::EpiBf16 E{(bf16_t*)(ws + WS_KB) + (size_t)ll * 1024 * 2048, 2048, nullptr, 1.0f, -1};
    pg8::gemm_phase<pg8::EpiBf16, pg8::StaticOrder, true>(lds, g, S, E);
}
__device__ __forceinline__ void vwo_gemm(LAS unsigned char* lds, unsigned char* ws, int ll, int b, int G, int c2) {
    pg8::Gemm g; g.A = (const bf16_t*)(ws + WS_W + (size_t)ll * W_LAYER + W_O); g.Bt = (const bf16_t*)(ws + WS_KB) + (size_t)ll * 1024 * 2048 + (size_t)b * 256 * 2048 + 1024;
    g.lda = 1024; g.ldb = 2048; g.K = 256; g.a_pm = 256L * 1024; g.a_pn = 256; g.b_pn = 256; g.b_pb = 0; g.b_pm = 0;
    pg8::StaticOrder S; S.init(1024, 1024, G, c2);
    pg8::EpiBf16 E{(bf16_t*)(ws + WS_VWO) + (size_t)b * 1024 * 1024, 1024, nullptr, 1.0f, -1};
    pg8::gemm_phase<pg8::EpiBf16, pg8::StaticOrder, true>(lds, g, S, E);
}

__device__ __forceinline__ void kq_gemm(LAS unsigned char* lds, unsigned char* ws, int ll, int b, int G, int c2) {
    pg8::Gemm g; g.A = (const bf16_t*)(ws + WS_KB) + (size_t)ll * 1024 * 2048 + (size_t)b * 256 * 2048; g.Bt = (const bf16_t*)(ws + WS_W + (size_t)ll * W_LAYER + W_Q);
    g.lda = 2048; g.ldb = 1024; g.K = 256; g.a_pm = 256; g.a_pn = 0; g.b_pn = 256L * 1024; g.b_pb = 0; g.b_pm = 256;
    pg8::StaticOrder S; S.init(1024, 1024, G, c2);
    pg8::EpiBf16 E{(bf16_t*)(ws + WS_KQ) + (size_t)b * 1024 * 1024, 1024, nullptr, 1.0f, -1};
    pg8::gemm_phase<pg8::EpiBf16, pg8::StaticOrder, true>(lds, g, S, E);
}

__global__ void __launch_bounds__(NTHR, 2) mk_fwd(Args args) {
    extern __shared__ __attribute__((aligned(16))) unsigned char lds_raw[];
    LAS unsigned char* lds = (LAS unsigned char*)lds_raw;
    const int tid = threadIdx.x, lane = tid & 63, wave = __builtin_amdgcn_readfirstlane(tid >> 6);
    const int G = gridDim.x, bx0 = blockIdx.x;
    const int gw = bx0 * NWAVES + wave, NGW = G * NWAVES;
    unsigned char* ws = args.ws;
    float* X = args.out;
    bf16_t* XB = (bf16_t*)(ws + WS_XB); float* SS = (float*)(ws + WS_SS);
    bf16_t* ACT = (bf16_t*)(ws + WS_R); bf16_t* Zb = ACT; bf16_t* Yb = ACT + 2048;
    bf16_t* Pb = ACT;
    const int lo = args.ph_lo, hi = args.ph_hi;
    cg::grid_group grid = cg::this_grid();
    volatile LAS unsigned* bst = (volatile LAS unsigned*)(lds + RING_BYTES + 8192);
    if (tid < 4) bst[tid] = 0u;
    __syncthreads();
    XcdBarrier xbar; xbar.bar = (unsigned*)(ws + WS_CTL); xbar.x = 0; xbar.st = bst;
    if (hi - lo > 1) xbar = xcd_barrier_post((unsigned*)(ws + WS_CTL), bst);
    const bool fuse_final = (lo == 0 && hi == NPH && G == 256);
    if (lo < 0) grid.sync();
#define IN(k) (lo <= (k) && (k) < hi)
#define SEAMF(k, f) do { if (IN(k) && IN((k) + 1)) { xcd_barrier(xbar, (f) || !loc); if (PROBE_MASK & (1 << 10)) xcd_barrier(xbar); } } while (0)
#define SEAM(k) SEAMF(k, true)
#define SEAML(k) do { if (IN(k) && IN((k) + 1)) { if (gcnt) group_barrier(gcnt); else xcd_barrier(xbar, true, false); if (PROBE_MASK & (1 << 10)) xcd_barrier(xbar); } } while (0)
#define WG_SEAM() do { asm volatile("s_waitcnt vmcnt(0)" ::: "memory"); __syncthreads(); } while (0)
#define REP(cls) for (int rep_ = 0; rep_ < ((PROBE_MASK >> (cls)) & 1) + 1; ++rep_)

    bool loc = false;
    if (IN(0)) REP(0) p0_prologue(args, lds, gw, NGW, wave, lane);
    SEAM(0);
    int bx = bx0;
    if (IN(0) && IN(1) && bst[2] != 0u) { bx = (int)(bst[3] * 8u + xbar.x); loc = true; }
    bx = __builtin_amdgcn_readfirstlane(bx);
    unsigned* gcnt = loc ? (unsigned*)(ws + WS_CTL) + 8192 + 64 * (bx & 63) : nullptr;
    if ((PROBE_MASK & (1 << 12)) && IN(0) && IN(1) && !loc) { for (int i_ = 0; i_ < 20; ++i_) xcd_barrier(xbar); }
#pragma unroll 1
    for (int l = 0; l < 2; ++l) {
        const int pb = 1 + 11 * l;
        unsigned char* wl = ws + WS_W + (size_t)l * W_LAYER;
        if (IN(pb + 0)) {
            if (l == 0) {
                kv_gemm(lds, ws, 0, G, (bx + 2 * G - 128) % G);
                if (bx >= 160) convert_group<1>(args, lds, (bx - 160) * NWAVES + wave, (G - 160) * NWAVES, wave, lane);
            } else { if (bx >= 128) convert_group<3>(args, lds, (bx - 128) * NWAVES + wave, (G - 128) * NWAVES, wave, lane); }
            __syncthreads();
            REP(1) { pg8::Gemm g = pg8::plain_gemm(XB, (const bf16_t*)(wl + W_1IN), D); pg8::StaticOrder S; S.init(M, 2 * DFF, G, bx);
              pg8::EpiSwiGLU E{ACT, SS, build_rs_table(SS, S, lds, tid)}; pg8::gemm_phase<pg8::EpiSwiGLU, pg8::StaticOrder, true>(lds, g, S, E); }
        }
        SEAML(pb + 0);
        if (IN(pb + 1)) REP(2) { pg8::Gemm g = pg8::plain_gemm(ACT, (const bf16_t*)(wl + W_1OUT), DFF); g.lda = LDR; g.a_pm = 256L * LDR; pg8::StaticOrder S; S.init(M, D, G, bx);
            pg8::EpiResid E{XB, SS, rep_ == 0 ? 0.5f : 0.f}; pg8::gemm_phase<pg8::EpiResid, pg8::StaticOrder, false>(lds, g, S, E); }
        SEAML(pb + 1);
        if (IN(pb + 2)) REP(3) { pg8::Gemm g = pg8::plain_gemm(XB, (const bf16_t*)(wl + W_MIXIN), D); pg8::StaticOrder S; S.init(M, DZ, G, bx);
            pg8::EpiBf16 E{Zb, ZS, SS, 1.0f, build_rs_table(SS, S, lds, tid)}; pg8::gemm_phase<pg8::EpiBf16, pg8::StaticOrder, true>(lds, g, S, E); }
        SEAM(pb + 2);
        if (IN(pb + 3)) REP(4) {
            for (int u = bx; u < 768; u += G) {
                int ptid = tid; asm volatile("" : "+v"(ptid));
                if (u < 256) mixer_c(Zb, Yb, args.in[11] + l * 31 * 256, args.in[12] + l * 256, args.in[13] + l * 256, lds, u, ptid);
                else if (u < 512) mixer_d(Zb, Yb, args.in[14] + (size_t)l * 4 * 64 * 64, args.in[15] + l * 256, lds, u - 256, ptid);
                else if (u < 640) mixer_b(Zb, Yb, args.in[8] + l * 256, args.in[9] + (size_t)l * 4 * 128 * 128, args.in[10] + l * 4 * 128, lds, u - 512, ptid);
                else mixer_a(Zb, Yb, args.in[7] + l * 3 * 256, u - 640, ptid);
            }
            for (int b = 0; b < 4; ++b) vwo_gemm(lds, ws, l, b, G, (bx + 2 * G - 192 - 16 * b) % G);
            for (int b = 0; b < 4; ++b) kq_gemm(lds, ws, l, b, G, (bx + 2 * G - 128 - 16 * b) % G);
        }
        SEAM(pb + 3);
        if (IN(pb + 4)) REP(5) { pg8::Gemm g = pg8::plain_gemm(Yb, (const bf16_t*)(wl + W_MIXOUT), D); g.lda = LDR; g.a_pm = 256L * LDR; if (PROBE_K2 && rep_ == 1) g.K = PROBE_K2;
            pg8::StaticOrder S; S.init(M, D, G, bx);
            pg8::EpiResid E{XB, SS, rep_ == 0 ? 1.0f : 0.f}; pg8::gemm_phase<pg8::EpiResid, pg8::StaticOrder, false>(lds, g, S, E); }
        SEAML(pb + 4);
        if (IN(pb + 5)) REP(6) { pg8::Gemm g = pg8::plain_gemm(XB, (const bf16_t*)(ws + WS_KQ), D); g.b_pb = 1024L * 1024; pg8::StaticOrder S; S.init(M, D, G, bx);
            pg8::EpiSoftmax E{Pb, SS, QSCALE, build_rs_table(SS, S, lds, tid)}; pg8::gemm_phase<pg8::EpiSoftmax, pg8::StaticOrder, false>(lds, g, S, E); }
        SEAML(pb + 7);
        if (IN(pb + 8)) REP(9) { pg8::Gemm g = pg8::plain_gemm(Pb, (const bf16_t*)(ws + WS_VWO), D); g.b_pb = 1024L * 1024; g.lda = LDR; g.a_pm = 256L * LDR; pg8::StaticOrder S; S.init(M, D, G, bx);
            pg8::EpiResid E{XB, SS, rep_ == 0 ? 1.0f : 0.f}; pg8::gemm_phase<pg8::EpiResid, pg8::StaticOrder, false>(lds, g, S, E); }
        SEAML(pb + 8);
        if (IN(pb + 9)) {
            if (l == 0) {
                kv_gemm(lds, ws, 1, G, (bx + 2 * G - 128) % G);
                if (bx >= 160) { convert_group<2>(args, lds, (bx - 160) * NWAVES + wave, (G - 160) * NWAVES, wave, lane);
                    asm volatile("s_waitcnt vmcnt(0)" ::: "memory"); __syncthreads();
                    if (tid == 0) xb_add((unsigned*)(ws + WS_CTL) + CW_G2, 1u); }
            }
            __syncthreads();
            REP(1) { pg8::Gemm g = pg8::plain_gemm(XB, (const bf16_t*)(wl + W_2IN), D); pg8::StaticOrder S; S.init(M, 2 * DFF, G, bx);
            pg8::EpiSwiGLU E{ACT, SS, build_rs_table(SS, S, lds, tid)}; pg8::gemm_phase<pg8::EpiSwiGLU, pg8::StaticOrder, true>(lds, g, S, E); } }
        SEAML(pb + 9);
        if (IN(pb + 10)) {
            if (l == 0 && IN(pb + 9)) {
                if (tid == 0) { unsigned sp = 0u; while (xb_ld((unsigned*)(ws + WS_CTL) + CW_G2) < (unsigned)(G - 160)) { __builtin_amdgcn_s_sleep(2); if (++sp > (XB_SPIN_CAP << 4)) break; }
                    __builtin_amdgcn_fence(__ATOMIC_ACQUIRE, "agent"); asm volatile("s_waitcnt vmcnt(0)" ::: "memory"); }
                __syncthreads();
            }
            if (l == 1 && fuse_final) {
                pg8::Gemm g = pg8::plain_gemm(ACT, (const bf16_t*)(wl + W_2OUT), DFF); g.lda = LDR; g.a_pm = 256L * LDR; pg8::StaticOrder S; S.init(M, D, G, bx);
                EpiFinal E{XB, SS, args.in[25], X, 0.5f, xbar, !loc, gcnt}; pg8::gemm_phase<EpiFinal, pg8::StaticOrder, false>(lds, g, S, E);
            } else REP(2) { pg8::Gemm g = pg8::plain_gemm(ACT, (const bf16_t*)(wl + W_2OUT), DFF); g.lda = LDR; g.a_pm = 256L * LDR; pg8::StaticOrder S; S.init(M, D, G, bx);
                pg8::EpiResid E{XB, SS, rep_ == 0 ? 0.5f : 0.f}; pg8::gemm_phase<pg8::EpiResid, pg8::StaticOrder, false>(lds, g, S, E); } }
        if (l == 0) SEAML(pb + 10); else if (!fuse_final) SEAMF(pb + 10, true);
    }
    if (IN(23) && !fuse_final) REP(11) {
        const f32x4* gf = (const f32x4*)args.in[25] + lane;
        for (int m = gw; m < M; m += NGW) { const float rs = pg8::row_rs(SS, m); const u32x2* xr = (const u32x2*)(XB + (size_t)m * D) + lane; f32x4* orow = (f32x4*)(X + (size_t)m * D) + lane;
#pragma unroll
            for (int j = 0; j < 4; ++j) { const u32x2 u = xr[64 * j]; const f32x4 v = (f32x4){bf_lo(u.x), bf_hi(u.x), bf_lo(u.y), bf_hi(u.y)};
                orow[64 * j] = v * rs * gf[64 * j]; } }
    }
#undef IN
#undef SEAM
#undef SEAML
#undef REP
#undef WG_SEAM
}
}
#define MK_MODE 0

#ifndef MK_MODE
#define MK_MODE 0
#endif
extern "C" void kernel_launch(void* const* d_in, const int* in_sizes, int n_in, void* d_out, int out_size, void* d_ws, size_t ws_size, hipStream_t stream) {
    using namespace mk;
    static int grid = 0;
    if (grid == 0) {
        if (n_in != 26 || out_size != M * D || ws_size < WS_END) { fprintf(stderr, "kernel_launch: unexpected shapes (n_in %d out %d ws %zu)\n", n_in, out_size, ws_size); grid = -1; return; }
        int dev = 0, cus = 0, per_cu = 0;
        hipGetDevice(&dev); hipDeviceGetAttribute(&cus, hipDeviceAttributeMultiprocessorCount, dev);
        if (hipFuncSetAttribute((const void*)mk_fwd, hipFuncAttributeMaxDynamicSharedMemorySize, LDS_BYTES) != hipSuccess) { fprintf(stderr, "kernel_launch: hipFuncSetAttribute failed\n"); grid = -1; return; }
        if (hipOccupancyMaxActiveBlocksPerMultiprocessor(&per_cu, (const void*)mk_fwd, NTHR, LDS_BYTES) != hipSuccess || per_cu < 1) { fprintf(stderr, "kernel_launch: occupancy query failed (%d)\n", per_cu); per_cu = 1; }
        (void)hipGetLastError();
        grid = cus * per_cu;
        if (grid != 256) { fprintf(stderr, "kernel_launch: built for a 256-workgroup grid (256 CUs x 1 workgroup), got %d; nothing launched\n", grid); grid = -1; return; }
        fprintf(stderr, "kernel_launch: cus %d per_cu %d grid %d\n", cus, per_cu, grid);
    }
    if (grid < 0) return;
    Args a{};
    for (int i = 0; i < 26; ++i) a.in[i] = (const float*)d_in[i];
    a.out = (float*)d_out; a.ws = (unsigned char*)d_ws;
#if MK_MODE == 0
    a.ph_lo = 0; a.ph_hi = NPH;
    if (hipMemsetAsync((char*)d_ws + WS_CTL, 0, 65536, stream) != hipSuccess) { fprintf(stderr, "kernel_launch: memset of the barrier words failed\n"); return; }
    void* kargs[] = {&a};
    hipError_t e = hipLaunchCooperativeKernel((const void*)mk_fwd, dim3(grid), dim3(NTHR), kargs, LDS_BYTES, stream);
    if (e != hipSuccess) fprintf(stderr, "kernel_launch: cooperative launch failed: %s (grid %d)\n", hipGetErrorString(e), grid);
#else
    for (int p = 0; p < NPH; ++p) { a.ph_lo = p; a.ph_hi = p + 1; hipLaunchKernelGGL(mk_fwd, dim3(grid), dim3(NTHR), LDS_BYTES, stream, a); }
#endif
}
```

```cpp
#include <hip/hip_runtime.h>
#include <hip/hip_cooperative_groups.h>
#include <cstdio>
#include <cstdint>
namespace cg = cooperative_groups;
namespace pg8 {
#define PG8_LAS __attribute__((address_space(3)))
typedef unsigned short bf16_t;
typedef short bf16x8 __attribute__((ext_vector_type(8)));
typedef float f32x4 __attribute__((ext_vector_type(4)));
typedef float f32x2 __attribute__((ext_vector_type(2)));
typedef unsigned u32x4 __attribute__((ext_vector_type(4)));
typedef unsigned u32x2 __attribute__((ext_vector_type(2)));
constexpr int LDR = 3072;
constexpr int BM = 256, BK = 64, HALF = 128, HTB = HALF * BK * 2, STAGE_BYTES = 8 * HTB, NXCD = 8, WGM = 8;

__host__ __device__ __forceinline__ int lds_byte(int r, int c) { const int st = (r >> 4) * 2 + (c >> 5), rr = r & 15, cc = c & 31, ob = rr * 64 + cc * 2; return st * 1024 + (ob ^ (((ob >> 9) & 1) << 5)); }
__host__ __device__ __forceinline__ void stage_rc(int b, int& R, int& C) { const int st = b / 1024, sb = b % 1024, swz = sb ^ (((sb >> 9) & 1) << 5); R = (st >> 1) * 16 + swz / 64; C = (st & 1) * 32 + (swz % 64) / 2; }
__host__ __device__ __forceinline__ int perm32(int rho) { const int n = rho >> 4, i = rho & 15; return 8 * (i >> 2) + 4 * n + (i & 3); }

struct Unit { int pm, pn; };
struct Gemm { const bf16_t* A; const bf16_t* Bt; int lda, ldb, K; long a_pm, a_pn, b_pn, b_pb, b_pm; };
__device__ __forceinline__ Gemm plain_gemm(const bf16_t* A, const bf16_t* Bt, int K) { Gemm g; g.A = A; g.Bt = Bt; g.lda = K; g.ldb = K; g.K = K; g.a_pm = 256L * K; g.a_pn = 0; g.b_pn = 256L * K; g.b_pb = 0; g.b_pm = 0; return g; }

struct StaticOrder {
    int nM, nN, nwg, G, c;
    __host__ __device__ void init(int M, int N, int G_, int c_) { nM = M / BM; nN = N / BM; nwg = nM * nN; G = G_; c = c_; }
    __host__ __device__ bool next(int i, Unit& u) const {
        const long L = (long)i * G + c; if (L >= nwg) return false;
        int wgid = (int)L; { const int q = nwg / NXCD, r = nwg % NXCD, xcd = wgid % NXCD, off = wgid / NXCD; wgid = (xcd < r ? xcd * (q + 1) : r * (q + 1) + (xcd - r) * q) + off; }
        const int nig = WGM * nN, gid = wgid / nig, fm = gid * WGM, gsz = (nM - fm) < WGM ? (nM - fm) : WGM;
        u.pm = fm + ((wgid % nig) % gsz); u.pn = (wgid % nig) / gsz; return true;
    }
};

typedef __bf16 bf16x2_n __attribute__((ext_vector_type(2)));
__device__ __forceinline__ unsigned cvt_pk_bf16(float lo, float hi) { const f32x2 v = {lo, hi}; return __builtin_bit_cast(unsigned, __builtin_convertvector(v, bf16x2_n)); }

#ifndef WT_STORES
#define WT_STORES 0
#endif
__device__ __forceinline__ void st16(void* p, u32x4 v) {
#if WT_STORES
    asm volatile("global_store_dwordx4 %0, %1, off sc1\n\ts_nop 1" :: "v"(p), "v"(v) : "memory");
#else
    *(u32x4*)p = v;
#endif
}
__device__ __forceinline__ float row_rs(const float* ss, int row) {
    const f32x4 a = *(const f32x4*)(ss + (size_t)row * 4);
    const float s = (a[0] + a[1]) + (a[2] + a[3]);
    return __builtin_amdgcn_rsqf(s * (1.0f / 1024.0f) + 1e-6f);
}
__device__ __forceinline__ float fast_silu(float g) { return g * __builtin_amdgcn_rcpf(1.0f + __expf(-g)); }


struct EpiBf16 {
    static constexpr bool PERM = true, AFTER_DRAIN = false, RESID_PREFETCH = false;
    bf16_t* O; int ldc; const float* ss; float scale; int tab_pm;
    __device__ __forceinline__ void operator()(const f32x4 (&acc)[2][2][4][2], const Unit& u, int wr, int wc, int fr, int fq, PG8_LAS unsigned char* spare, int tid) const {
        const int row0 = u.pm * BM + wr * 64 + fr, col0 = u.pn * BM + wc * 32 + 8 * fq; const PG8_LAS float* tab = (const PG8_LAS float*)(spare + 4096);
#pragma unroll
        for (int ai = 0; ai < 2; ++ai)
#pragma unroll
            for (int m = 0; m < 4; ++m) { const int row = row0 + ai * HALF + m * 16; const float sc = ss ? tab[row - u.pm * BM] * scale : scale;
                bf16_t* rowp = O + (size_t)row * ldc + col0;
#pragma unroll
                for (int bj = 0; bj < 2; ++bj) { const f32x4 v0 = acc[ai][bj][m][0] * sc, v1 = acc[ai][bj][m][1] * sc;
                    u32x4 w; w.x = cvt_pk_bf16(v0[0], v0[1]); w.y = cvt_pk_bf16(v0[2], v0[3]); w.z = cvt_pk_bf16(v1[0], v1[1]); w.w = cvt_pk_bf16(v1[2], v1[3]);
                    st16(rowp + bj * HALF, w); } }
    }
};
struct EpiSwiGLU {
    static constexpr bool PERM = true, AFTER_DRAIN = false, RESID_PREFETCH = false;
    bf16_t* O; const float* ss; int tab_pm;
    __device__ __forceinline__ void operator()(const f32x4 (&acc)[2][2][4][2], const Unit& u, int wr, int wc, int fr, int fq, PG8_LAS unsigned char* spare, int tid) const {
        const int row0 = u.pm * BM + wr * 64 + fr, col0 = u.pn * HALF + wc * 32 + 8 * fq; const PG8_LAS float* tab = (const PG8_LAS float*)(spare + 4096);
#pragma unroll
        for (int ai = 0; ai < 2; ++ai)
#pragma unroll
            for (int m = 0; m < 4; ++m) { const int row = row0 + ai * HALF + m * 16; const float sc = tab[row - u.pm * BM];
                const float sc2 = sc * sc, sce = sc * -1.4426950408889634f;
                f32x4 e0 = acc[ai][0][m][0] * sce, e1 = acc[ai][0][m][1] * sce;
#pragma unroll
                for (int e = 0; e < 4; ++e) { e0[e] = __builtin_amdgcn_exp2f(e0[e]); e1[e] = __builtin_amdgcn_exp2f(e1[e]); }
                e0 = e0 + 1.0f; e1 = e1 + 1.0f;
#pragma unroll
                for (int e = 0; e < 4; ++e) { e0[e] = __builtin_amdgcn_rcpf(e0[e]); e1[e] = __builtin_amdgcn_rcpf(e1[e]); }
                const f32x4 o0 = (acc[ai][0][m][0] * acc[ai][1][m][0]) * (e0 * sc2), o1 = (acc[ai][0][m][1] * acc[ai][1][m][1]) * (e1 * sc2);
                u32x4 w; w.x = cvt_pk_bf16(o0[0], o0[1]); w.y = cvt_pk_bf16(o0[2], o0[3]); w.z = cvt_pk_bf16(o1[0], o1[1]); w.w = cvt_pk_bf16(o1[2], o1[3]);
                st16(O + (size_t)row * LDR + col0, w); }
    }
};
struct EpiResid {
    static constexpr bool PERM = true, AFTER_DRAIN = true, RESID_PREFETCH = true;
    bf16_t* xb; float* ss; float alpha;
    __device__ __forceinline__ void fused(f32x4 (&acc)[2][2][4][2], const Unit& u, int wr, int wc, int fr, int fq, PG8_LAS unsigned char* lds, int wid, int lane) const {
        PG8_LAS float* Pq = (PG8_LAS float*)(lds + STAGE_BYTES);
        const int tid = wid * 64 + lane, h = wc >> 1;
        const int row0 = u.pm * BM + wr * 64 + fr, col0 = u.pn * BM + wc * 32 + 8 * fq;
        u32x4 g7[4];
        if (h) {
#pragma unroll
            for (int m = 0; m < 4; ++m) g7[m] = *(const u32x4*)(xb + (size_t)(row0 + HALF + m * 16) * 1024 + col0 + HALF);
        }
#pragma unroll
        for (int ai = 0; ai < 2; ++ai)
#pragma unroll
            for (int m = 0; m < 4; ++m) { const int row = row0 + ai * HALF + m * 16; bf16_t* rowp = xb + (size_t)row * 1024 + col0; float q = 0.f;
                const int poff = lds_byte(wr * 64 + m * 16 + fr, (wc & 1) * 32 + 8 * fq);
#pragma unroll
                for (int bj = 0; bj < 2; ++bj) {
                    const int slot = ai == 0 ? (bj == 0 ? 4 + h : h) : (bj == 0 ? 6 + h : 2);
                    u32x4 b = *(const PG8_LAS u32x4*)(lds + slot * HTB + poff);
                    if (ai == 1 && bj == 1) { if (h) b = g7[m]; }
                    const f32x4 o0 = (f32x4){__uint_as_float(b.x << 16), __uint_as_float(b.x & 0xffff0000u), __uint_as_float(b.y << 16), __uint_as_float(b.y & 0xffff0000u)} + acc[ai][bj][m][0] * alpha;
                    const f32x4 o1 = (f32x4){__uint_as_float(b.z << 16), __uint_as_float(b.z & 0xffff0000u), __uint_as_float(b.w << 16), __uint_as_float(b.w & 0xffff0000u)} + acc[ai][bj][m][1] * alpha;
                    u32x4 w; w.x = cvt_pk_bf16(o0[0], o0[1]); w.y = cvt_pk_bf16(o0[2], o0[3]); w.z = cvt_pk_bf16(o1[0], o1[1]); w.w = cvt_pk_bf16(o1[2], o1[3]);
                    st16(rowp + bj * HALF, w);
                    q += ((o0[0] * o0[0] + o0[1] * o0[1]) + (o0[2] * o0[2] + o0[3] * o0[3])) + ((o1[0] * o1[0] + o1[1] * o1[1]) + (o1[2] * o1[2] + o1[3] * o1[3])); }
                q += __shfl_xor(q, 16); q += __shfl_xor(q, 32);
                if (fq == 0) Pq[(ai * HALF + wr * 64 + m * 16 + fr) * 4 + wc] = q; }
        asm volatile("s_waitcnt lgkmcnt(0)" ::: "memory"); __builtin_amdgcn_s_barrier(); asm volatile("" ::: "memory");
        if (tid < 256) { const f32x4 v = *(const PG8_LAS f32x4*)(Pq + tid * 4); ss[(size_t)(u.pm * BM + tid) * 4 + u.pn] = (v[0] + v[1]) + (v[2] + v[3]); }
    }
};
struct EpiSoftmax {
    static constexpr bool PERM = true, AFTER_DRAIN = true, RESID_PREFETCH = false;
    bf16_t* P; const float* ss; float scale; int tab_pm;
    __device__ __forceinline__ void fused(f32x4 (&acc)[2][2][4][2], const Unit& u, int wr, int wc, int fr, int fq, PG8_LAS unsigned char* lds, int wid, int lane) const {
        PG8_LAS float* Pm = (PG8_LAS float*)lds;
        PG8_LAS float* Ps = (PG8_LAS float*)(lds + 4096);
#pragma unroll
        for (int ai = 0; ai < 2; ++ai)
#pragma unroll
            for (int m = 0; m < 4; ++m) { const int rt = ai * HALF + wr * 64 + m * 16 + fr; const float sc = ((const PG8_LAS float*)(lds + STAGE_BYTES + 4096))[rt] * scale;
#pragma unroll
                for (int bj = 0; bj < 2; ++bj)
#pragma unroll
                    for (int n = 0; n < 2; ++n) acc[ai][bj][m][n] = acc[ai][bj][m][n] * sc; }
#pragma unroll
        for (int ai = 0; ai < 2; ++ai)
#pragma unroll
            for (int m = 0; m < 4; ++m) { float mx = -3.0e38f;
#pragma unroll
                for (int bj = 0; bj < 2; ++bj)
#pragma unroll
                    for (int n = 0; n < 2; ++n) { const f32x4 x = acc[ai][bj][m][n]; mx = fmaxf(mx, fmaxf(fmaxf(x[0], x[1]), fmaxf(x[2], x[3]))); }
                mx = fmaxf(mx, __shfl_xor(mx, 16)); mx = fmaxf(mx, __shfl_xor(mx, 32));
                if (fq == 0) Pm[(ai * HALF + wr * 64 + m * 16 + fr) * 4 + wc] = mx; }
        asm volatile("s_waitcnt lgkmcnt(0)" ::: "memory"); __builtin_amdgcn_s_barrier(); asm volatile("" ::: "memory");
#pragma unroll
        for (int ai = 0; ai < 2; ++ai)
#pragma unroll
            for (int m = 0; m < 4; ++m) { const int r = ai * HALF + wr * 64 + m * 16 + fr; const f32x4 pm4 = *(const PG8_LAS f32x4*)(Pm + r * 4);
                const float mx = fmaxf(fmaxf(pm4[0], pm4[1]), fmaxf(pm4[2], pm4[3])); float s = 0.f;
#pragma unroll
                for (int bj = 0; bj < 2; ++bj)
#pragma unroll
                    for (int n = 0; n < 2; ++n) { f32x4 x = acc[ai][bj][m][n];
                        x[0] = __builtin_amdgcn_exp2f(x[0] - mx); x[1] = __builtin_amdgcn_exp2f(x[1] - mx); x[2] = __builtin_amdgcn_exp2f(x[2] - mx); x[3] = __builtin_amdgcn_exp2f(x[3] - mx);
                        acc[ai][bj][m][n] = x; s += (x[0] + x[1]) + (x[2] + x[3]); }
                s += __shfl_xor(s, 16); s += __shfl_xor(s, 32);
                if (fq == 0) Ps[r * 4 + wc] = s; }
        asm volatile("s_waitcnt lgkmcnt(0)" ::: "memory"); __builtin_amdgcn_s_barrier(); asm volatile("" ::: "memory");
        const int col0 = u.pn * BM + wc * 32 + 8 * fq;
#pragma unroll
        for (int ai = 0; ai < 2; ++ai)
#pragma unroll
            for (int m = 0; m < 4; ++m) { const int r = ai * HALF + wr * 64 + m * 16 + fr; const f32x4 ps4 = *(const PG8_LAS f32x4*)(Ps + r * 4);
                const float inv = 1.0f / ((ps4[0] + ps4[1]) + (ps4[2] + ps4[3]));
                bf16_t* rowp = P + (size_t)(u.pm * BM + r) * LDR + col0;
#pragma unroll
                for (int bj = 0; bj < 2; ++bj) { const f32x4 v0 = acc[ai][bj][m][0] * inv, v1 = acc[ai][bj][m][1] * inv;
                    u32x4 w; w.x = cvt_pk_bf16(v0[0], v0[1]); w.y = cvt_pk_bf16(v0[2], v0[3]); w.z = cvt_pk_bf16(v1[0], v1[1]); w.w = cvt_pk_bf16(v1[2], v1[3]);
                    st16(rowp + bj * HALF, w); } }
        asm volatile("s_waitcnt lgkmcnt(0)" ::: "memory"); __builtin_amdgcn_s_barrier(); asm volatile("" ::: "memory");
    }
};

template <class Epi, class Sched, bool ALIGN_EPI>
__device__ __forceinline__ void gemm_phase(PG8_LAS unsigned char* lds, const Gemm g, const Sched& S, const Epi& E) {
    int tid_ = threadIdx.x; asm volatile("" : "+v"(tid_));
    const int tid = tid_, wid = __builtin_amdgcn_readfirstlane(tid >> 6), lane = tid & 63, wr = wid >> 2, wc = wid & 3, fr = lane & 15, fq = lane >> 4;
    const int K = g.K, nt = K / BK;
    unsigned voffA[2], voffB[2];
#pragma unroll
    for (int i = 0; i < 2; ++i) { int R, C; stage_rc(tid * 16 + i * 8192, R, C); const int Rb = Epi::PERM ? ((R & ~31) + perm32(R & 31)) : R;
        voffA[i] = (unsigned)(R * g.lda + C) * 2u; voffB[i] = (unsigned)(Rb * g.ldb + C) * 2u; }
    const size_t kstep = (size_t)(BK * 2);
    const size_t hstepA = (size_t)HALF * g.lda * 2, hstepB = (size_t)HALF * g.ldb * 2;
    const unsigned ldsw = (unsigned)wid * 1024u;
    const int aoff = lds_byte(wr * 64 + fr, fq * 8), boff = lds_byte(wc * 32 + fr, fq * 8);
#define PG8_SA(b, h) (((b) * 2 + (h)) * HTB)
#define PG8_SB(b, h) ((4 + (b) * 2 + (h)) * HTB)
#define PG8_STAGE(bufoff, gbase, voff) do { _Pragma("unroll") for (int _i = 0; _i < 2; ++_i) \
        __builtin_amdgcn_global_load_lds((const unsigned*)((const char*)(gbase) + (voff)[_i]), (PG8_LAS unsigned*)(lds + (bufoff) + ldsw + _i * 8192), 16, 0, 0); } while (0)
#define PG8_LDA(dst, b, h) do { _Pragma("unroll") for (int m = 0; m < 4; ++m) _Pragma("unroll") for (int k = 0; k < 2; ++k) dst[m][k] = *(const PG8_LAS bf16x8*)(lds + PG8_SA(b, h) + aoff + m * 2048 + k * 1024); } while (0)
#define PG8_LDB(dst, b, h) do { _Pragma("unroll") for (int n = 0; n < 2; ++n) _Pragma("unroll") for (int k = 0; k < 2; ++k) dst[n][k] = *(const PG8_LAS bf16x8*)(lds + PG8_SB(b, h) + boff + n * 2048 + k * 1024); } while (0)
#define PG8_MMA(ai, bj, At, Bt) do { __builtin_amdgcn_s_setprio(1); _Pragma("unroll") for (int m = 0; m < 4; ++m) _Pragma("unroll") for (int n = 0; n < 2; ++n) _Pragma("unroll") for (int k = 0; k < 2; ++k) \
        acc[ai][bj][m][n] = __builtin_amdgcn_mfma_f32_16x16x32_bf16(Bt[n][k], At[m][k], acc[ai][bj][m][n], 0, 0, 0); __builtin_amdgcn_s_setprio(0); } while (0)
#define PG8_WAIT_V(n) asm volatile("s_waitcnt vmcnt(" #n ")" ::: "memory")
#define PG8_WAIT_L(n) asm volatile("s_waitcnt lgkmcnt(" #n ")" ::: "memory")
#define PG8_BAR __builtin_amdgcn_s_barrier()
#define PG8_SCHED __builtin_amdgcn_sched_barrier(0)
#define PG8_APTR(u) ((const char*)g.A + ((size_t)(u).pm * g.a_pm + (size_t)(u).pn * g.a_pn) * 2)
#define PG8_BPTR(u) ((const char*)g.Bt + ((size_t)(u).pn * g.b_pn + (size_t)((u).pm >> 4) * g.b_pb + (size_t)(u).pm * g.b_pm) * 2)
    Unit cur, nxt; int ui = 0;
    if (!S.next(0, cur)) return;
    f32x4 acc[2][2][4][2];
#pragma unroll
    for (int a = 0; a < 2; ++a)
#pragma unroll
        for (int b = 0; b < 2; ++b)
#pragma unroll
            for (int m = 0; m < 4; ++m)
#pragma unroll
                for (int n = 0; n < 2; ++n) acc[a][b][m][n] = (f32x4){0.f, 0.f, 0.f, 0.f};
    bf16x8 At[4][2], B0[2][2], B1[2][2];
    const char* cA = PG8_APTR(cur); const char* cB = PG8_BPTR(cur);
    PG8_STAGE(PG8_SB(0, 0), cB, voffB); PG8_STAGE(PG8_SB(0, 1), cB + hstepB, voffB); PG8_STAGE(PG8_SA(0, 0), cA, voffA); PG8_STAGE(PG8_SA(0, 1), cA + hstepA, voffA);
    if (wr == 1) PG8_BAR;
    PG8_WAIT_V(2); PG8_BAR;
    PG8_STAGE(PG8_SB(1, 0), cB + kstep, voffB); PG8_STAGE(PG8_SA(1, 0), cA + kstep, voffA); PG8_STAGE(PG8_SB(1, 1), cB + hstepB + kstep, voffB);
    PG8_WAIT_V(6); PG8_BAR;
    for (;;) {
        const bool has_next = S.next(ui + 1, nxt);
        const char* nA = has_next ? PG8_APTR(nxt) : cA; const char* nB = has_next ? PG8_BPTR(nxt) : cB;
#define PG8_TRIP(a1h, pB00, vB00, pB01, vB01, pA00, vA00, pA01, vA01, pB10, vB10, pB11, vB11, pA10, vA10) do { \
            PG8_LDB(B0, 0, 0); PG8_LDB(B1, 0, 1); PG8_SCHED; PG8_LDA(At, 0, 0); PG8_STAGE(PG8_SA(1, 1), a1h, voffA); \
            PG8_WAIT_V(8); PG8_WAIT_L(0); PG8_BAR; PG8_MMA(0, 0, At, B0); PG8_MMA(0, 1, At, B1); PG8_BAR; PG8_SCHED; \
            PG8_LDA(At, 0, 1); PG8_STAGE(PG8_SB(0, 0), pB00, vB00); PG8_STAGE(PG8_SB(0, 1), pB01, vB01); PG8_STAGE(PG8_SA(0, 0), pA00, vA00); \
            PG8_WAIT_V(8); PG8_WAIT_L(0); PG8_BAR; PG8_MMA(1, 0, At, B0); PG8_MMA(1, 1, At, B1); PG8_BAR; PG8_SCHED; \
            PG8_LDB(B0, 1, 0); PG8_LDB(B1, 1, 1); PG8_SCHED; PG8_LDA(At, 1, 0); PG8_STAGE(PG8_SA(0, 1), pA01, vA01); \
            PG8_WAIT_V(8); PG8_WAIT_L(0); PG8_BAR; PG8_MMA(0, 0, At, B0); PG8_MMA(0, 1, At, B1); PG8_BAR; PG8_SCHED; \
            PG8_LDA(At, 1, 1); PG8_STAGE(PG8_SB(1, 0), pB10, vB10); PG8_STAGE(PG8_SB(1, 1), pB11, vB11); PG8_STAGE(PG8_SA(1, 0), pA10, vA10); \
            PG8_WAIT_V(8); PG8_WAIT_L(0); PG8_BAR; PG8_MMA(1, 0, At, B0); PG8_MMA(1, 1, At, B1); PG8_BAR; PG8_SCHED; } while (0)
        const int tend = Epi::RESID_PREFETCH ? nt - 2 : nt;
        for (int t = 0; t < tend; t += 2) {
            const bool last = (t == nt - 2);
            const char* a1 = cA + (size_t)(t + 1) * kstep;
            const char* a2 = last ? nA : cA + (size_t)(t + 2) * kstep; const char* b2 = last ? nB : cB + (size_t)(t + 2) * kstep;
            const char* a3 = a2 + kstep; const char* b3 = b2 + kstep;
            PG8_TRIP(a1 + hstepA, b2, voffB, b2 + hstepB, voffB, a2, voffA, a2 + hstepA, voffA, b3, voffB, b3 + hstepB, voffB, a3, voffA);
        }
        if constexpr (Epi::RESID_PREFETCH) {
            unsigned voffR[2];
#pragma unroll
            for (int i = 0; i < 2; ++i) { int R, C; stage_rc(tid * 16 + i * 8192, R, C); voffR[i] = (unsigned)(R * 1024 + C) * 2u; }
            const char* rb = (const char*)E.xb + ((size_t)cur.pm * BM * 1024 + (size_t)cur.pn * BM) * 2; const size_t rh = (size_t)HALF * 1024 * 2;
            const char* a1 = cA + (size_t)(nt - 1) * kstep;
            PG8_TRIP(a1 + hstepA, rb, voffR, rb + 128, voffR, rb + 256, voffR, rb + 384, voffR, rb + rh, voffR, rb + rh + 128, voffR, rb + rh + 256, voffR);
        }
#undef PG8_TRIP
        if constexpr (ALIGN_EPI) { if (wr == 0) PG8_BAR; }
        if constexpr (!Epi::AFTER_DRAIN) { E(acc, cur, wr, wc, fr, fq, lds + STAGE_BYTES, tid); }
        if (!has_next) break;
#pragma unroll
        for (int a = 0; a < 2; ++a)
#pragma unroll
            for (int b = 0; b < 2; ++b)
#pragma unroll
                for (int m = 0; m < 4; ++m)
#pragma unroll
                    for (int n = 0; n < 2; ++n) acc[a][b][m][n] = (f32x4){0.f, 0.f, 0.f, 0.f};
        cur = nxt; cA = nA; cB = nB; ++ui;
        if constexpr (ALIGN_EPI) { if (wr == 1) PG8_BAR; }
    }
    PG8_WAIT_V(0);
    if constexpr (!ALIGN_EPI) { if (wr == 0) PG8_BAR; }
    PG8_BAR;
    if constexpr (Epi::AFTER_DRAIN) { E.fused(acc, cur, wr, wc, fr, fq, lds, wid, lane); }
#undef PG8_SA
#undef PG8_SB
#undef PG8_STAGE
#undef PG8_LDA
#undef PG8_LDB
#undef PG8_MMA
#undef PG8_WAIT_V
#undef PG8_WAIT_L
#undef PG8_BAR
#undef PG8_SCHED
#undef PG8_APTR
#undef PG8_BPTR
}
}

#ifndef PROBE_MASK
#define PROBE_MASK 0
#endif
#ifndef PROBE_K2
#define PROBE_K2 0
#endif
#ifndef PROBE_EPI
#define PROBE_EPI 0
#endif
namespace mk {
using pg8::bf16_t; using pg8::bf16x8; using pg8::f32x4; using pg8::f32x2; using pg8::u32x4; using pg8::u32x2; using pg8::cvt_pk_bf16;
#define LAS __attribute__((address_space(3)))
constexpr int NWAVES = 8, NTHR = 512;
constexpr int D = 1024, BATCH = 4, SEQ = 4096, M = BATCH * SEQ, DFF = 2816, DZ = 2048, NMEM = 256;
constexpr int LDS_BYTES = 147456, RING_BYTES = 131072;
constexpr size_t MiB = 1u << 20;
constexpr size_t WS_CTL = 0, WS_SS = 1 * MiB, WS_MEMN = 2 * MiB, WS_KB = 6 * MiB, WS_VT = 10 * MiB, WS_W = 14 * MiB, WS_XB = 108 * MiB, WS_R = 140 * MiB, WS_VWO = 236 * MiB, WS_KQ = 244 * MiB, WS_END = 252 * MiB;
constexpr size_t W_LAYER = 47 * MiB;
constexpr size_t W_1IN = 0, W_1OUT = 11 * MiB, W_MIXIN = 16 * MiB + MiB / 2, W_MIXOUT = 20 * MiB + MiB / 2, W_Q = 22 * MiB + MiB / 2, W_KV = 24 * MiB + MiB / 2, W_O = 28 * MiB + MiB / 2,
                 W_2IN = 30 * MiB + MiB / 2, W_2OUT = 41 * MiB + MiB / 2;
constexpr int LDR = pg8::LDR, ZS = LDR, YS = LDR;
constexpr int NPH = 24;
constexpr float QSCALE = 1.4426950408889634f / 16.0f;

struct Args { const float* in[26]; float* out; unsigned char* ws; int ph_lo, ph_hi; };

__device__ __forceinline__ float wave_sum(float v) {
#pragma unroll
    for (int o = 1; o < 64; o <<= 1) v += __shfl_xor(v, o);
    return v;
}
__device__ __forceinline__ float bf_lo(unsigned u) { return __uint_as_float(u << 16); }
__device__ __forceinline__ float bf_hi(unsigned u) { return __uint_as_float(u & 0xffff0000u); }
#define LDS_WAIT() asm volatile("s_waitcnt lgkmcnt(0)" ::: "memory")


#define XB_TMO      128
#define XB_XCNT(j)  (256  + 64 * (j))
#define XB_XSUB(j)  (1280 + 64 * (j))
#define XB_XGEN(j)  (2304 + 64 * (j))
#define XB_TOP      3328
#define XB_TOPGEN   3392
#define XCD_BAR_WORDS 3456
#define XB_SPIN_CAP (1u << 20)
__device__ __forceinline__ unsigned xb_ld(unsigned* p)              { return __hip_atomic_load(p, __ATOMIC_RELAXED, __HIP_MEMORY_SCOPE_AGENT); }
__device__ __forceinline__ unsigned xb_add(unsigned* p, unsigned v) { return __hip_atomic_fetch_add(p, v, __ATOMIC_RELAXED, __HIP_MEMORY_SCOPE_AGENT); }
__device__ __forceinline__ unsigned xb_xcc_id() { return (unsigned)__builtin_amdgcn_s_getreg((3 << 11) | 20) & 0xFu; }
#define XB_SPIN(cond, bar) do { unsigned _sp = 0; while (cond) { __builtin_amdgcn_s_sleep(1); \
    if ((++_sp & 255u) == 0u) { if (xb_ld(&(bar)[XB_TMO])) break; if (_sp > XB_SPIN_CAP) { atomicAdd(&(bar)[XB_TMO], 1u); break; } } } } while (0)
struct XcdBarrier { unsigned* bar; unsigned x; volatile LAS unsigned* st; };
__device__ __forceinline__ XcdBarrier xcd_barrier_post(unsigned* bar, volatile LAS unsigned* st) {
    XcdBarrier b; b.bar = bar; b.x = xb_xcc_id(); b.st = st;
    if (threadIdx.x == 0) st[3] = xb_add(&bar[XB_XCNT(b.x)], 1u);
    return b;
}
__device__ __forceinline__ void xcd_barrier_complete(unsigned* bar, unsigned x, unsigned& nloc, unsigned& nx, unsigned& uni) {
    const unsigned G = gridDim.x * gridDim.y * gridDim.z;
    unsigned sum, cnt, mine, sp = 0u, u32 = 0u;
    for (;;) {
        sum = 0u; cnt = 0u; mine = 0u; u32 = 1u;
#pragma unroll
        for (unsigned j = 0; j < 16; ++j) { const unsigned c = xb_ld(&bar[XB_XCNT(j)]); sum += c; cnt += (c > 0u) ? 1u : 0u; mine = (j == x) ? c : mine; u32 &= (c == (j < 8u ? 32u : 0u)) ? 1u : 0u; }
        if (sum == G) break;
        __builtin_amdgcn_s_sleep(1);
        if ((++sp & 255u) == 0u) { if (xb_ld(&bar[XB_TMO])) break; if (sp > XB_SPIN_CAP) { atomicAdd(&bar[XB_TMO], 1u); break; } }
    }
    nloc = mine > 0u ? mine : 1u; nx = cnt > 0u ? cnt : 1u; uni = (sum == G && G == 256u) ? u32 : 0u;
}
__device__ __forceinline__ void xcd_barrier(const XcdBarrier& b, bool flush = true, bool local = false) {
    asm volatile("s_waitcnt vmcnt(0)" ::: "memory");
    __syncthreads();
    if (threadIdx.x == 0) {
        unsigned* bar = b.bar;
        __builtin_amdgcn_s_waitcnt(0);
        unsigned nloc = b.st[0], nx = b.st[1];
        if (nloc == 0u) { unsigned uni; xcd_barrier_complete(bar, b.x, nloc, nx, uni); b.st[0] = nloc; b.st[1] = nx; b.st[2] = uni; }
        const unsigned old = xb_add(&bar[XB_XSUB(b.x)], 1u);
        const unsigned gen = old / nloc;
        if (old + 1u == (gen + 1u) * nloc) {
            if (flush) { __builtin_amdgcn_fence(__ATOMIC_RELEASE, "agent");
            asm volatile("s_waitcnt vmcnt(0)" ::: "memory"); }
            if (!local) {
            const unsigned og = xb_add(&bar[XB_TOP], 1u);
            const unsigned tg = og / nx;
            if (og + 1u == (tg + 1u) * nx) xb_add(&bar[XB_TOPGEN], 1u);
            else XB_SPIN(xb_ld(&bar[XB_TOPGEN]) == tg, bar);
            }
            __builtin_amdgcn_fence(__ATOMIC_ACQUIRE, "agent");
            xb_add(&bar[XB_XGEN(b.x)], 1u);
            asm volatile("s_waitcnt vmcnt(0)" ::: "memory");
        } else {
            XB_SPIN(xb_ld(&bar[XB_XGEN(b.x)]) == gen, bar);
            __builtin_amdgcn_fence(__ATOMIC_ACQUIRE, "agent");
            asm volatile("s_waitcnt vmcnt(0)" ::: "memory");
        }
    }
    __syncthreads();
}

__device__ __forceinline__ void group_barrier(unsigned* gc) {
    asm volatile("s_waitcnt vmcnt(0)" ::: "memory");
    __syncthreads();
    if (threadIdx.x == 0) {
        __builtin_amdgcn_s_waitcnt(0);
        const unsigned old = xb_add(gc, 1u), target = (old / 4u + 1u) * 4u;
        unsigned sp = 0u;
        while (xb_ld(gc) < target) { __builtin_amdgcn_s_sleep(1); if (++sp > (XB_SPIN_CAP << 4)) break; }
        __builtin_amdgcn_fence(__ATOMIC_ACQUIRE, "agent");
        asm volatile("s_waitcnt vmcnt(0)" ::: "memory");
    }
    __syncthreads();
}

struct EpiFinal {
    static constexpr bool PERM = true, AFTER_DRAIN = true, RESID_PREFETCH = false;
    const bf16_t* xb; float* ss; const float* gfin; float* out; float alpha; XcdBarrier bar; bool flush; unsigned* gc;
    __device__ __forceinline__ void fused(f32x4 (&acc)[2][2][4][2], const pg8::Unit& u, int wr, int wc, int fr, int fq, LAS unsigned char* lds, int wid, int lane) const {
        LAS float* Pq = (LAS float*)lds;
        const int tid = wid * 64 + lane;
        const int row0 = u.pm * 256 + wr * 64 + fr, col0 = u.pn * 256 + wc * 32 + 8 * fq;
#pragma unroll
        for (int ai = 0; ai < 2; ++ai)
#pragma unroll
            for (int m = 0; m < 4; ++m) { const int row = row0 + ai * 128 + m * 16; const bf16_t* rowp = xb + (size_t)row * 1024 + col0; float q = 0.f;
#pragma unroll
                for (int bj = 0; bj < 2; ++bj) { const u32x4 b = *(const u32x4*)(rowp + bj * 128);
                    const f32x4 o0 = (f32x4){bf_lo(b.x), bf_hi(b.x), bf_lo(b.y), bf_hi(b.y)} + acc[ai][bj][m][0] * alpha;
                    const f32x4 o1 = (f32x4){bf_lo(b.z), bf_hi(b.z), bf_lo(b.w), bf_hi(b.w)} + acc[ai][bj][m][1] * alpha;
                    acc[ai][bj][m][0] = o0; acc[ai][bj][m][1] = o1;
                    q += ((o0[0] * o0[0] + o0[1] * o0[1]) + (o0[2] * o0[2] + o0[3] * o0[3])) + ((o1[0] * o1[0] + o1[1] * o1[1]) + (o1[2] * o1[2] + o1[3] * o1[3])); }
                q += __shfl_xor(q, 16); q += __shfl_xor(q, 32);
                if (fq == 0) Pq[(ai * 128 + wr * 64 + m * 16 + fr) * 4 + wc] = q; }
        __syncthreads();
        if (tid < 256) { const f32x4 v = *(const LAS f32x4*)(Pq + tid * 4); ss[(size_t)(u.pm * 256 + tid) * 4 + u.pn] = (v[0] + v[1]) + (v[2] + v[3]); }
        if (gc) group_barrier(gc); else xcd_barrier(bar, flush, !flush);
#pragma unroll
        for (int ai = 0; ai < 2; ++ai) {
            if (ai) __syncthreads();
#pragma unroll
            for (int m = 0; m < 4; ++m) { const int rl = wr * 64 + m * 16 + fr; const float rs = pg8::row_rs(ss, u.pm * 256 + ai * 128 + rl);
#pragma unroll
                for (int bj = 0; bj < 2; ++bj)
#pragma unroll
                    for (int n = 0; n < 2; ++n) { const int chunk = bj * 32 + wc * 8 + 2 * fq + n; const f32x4 g = *(const f32x4*)(gfin + u.pn * 256 + 4 * chunk);
                        *(LAS f32x4*)(lds + rl * 1024 + ((chunk ^ fr) * 16)) = acc[ai][bj][m][n] * rs * g; } }
            __syncthreads();
#pragma unroll 4
            for (int j = 0; j < 16; ++j) { const int rl = wid * 16 + j; const f32x4 v = *(const LAS f32x4*)(lds + rl * 1024 + ((lane ^ (rl & 15)) * 16));
                *(f32x4*)(out + (size_t)(u.pm * 256 + ai * 128 + rl) * 1024 + u.pn * 256 + 4 * lane) = v; }
        }
    }
};

__device__ __forceinline__ void p0_transpose_item(const float* W, int K, int N, bf16_t* WT, int dst_row0, const float* gk, LAS float* scr, int k0, int n0, int lane) {
    f32x4 v[16];
#pragma unroll
    for (int i = 0; i < 16; ++i) { const int kk = 4 * i + (lane >> 4); v[i] = *(const f32x4*)(W + (size_t)(k0 + kk) * N + n0 + 4 * (lane & 15)); }
    if (gk) {
#pragma unroll
        for (int i = 0; i < 16; ++i) { const int kk = 4 * i + (lane >> 4); v[i] = v[i] * gk[k0 + kk]; }
    }
#pragma unroll
    for (int i = 0; i < 16; ++i) { const int kk = 4 * i + (lane >> 4); *(LAS f32x4*)(scr + kk * 68 + ((4 * (lane & 15)) ^ (4 * ((kk >> 3) & 7)))) = v[i]; }
    LDS_WAIT(); asm volatile("" ::: "memory");
    const int c = lane & 7, nl = lane >> 3;
#pragma unroll
    for (int j = 0; j < 8; ++j) { const int n = nl + 8 * j; const LAS float* sp = scr + (8 * c) * 68 + (n ^ (4 * c));
        u32x4 o; o.x = cvt_pk_bf16(sp[0 * 68], sp[1 * 68]); o.y = cvt_pk_bf16(sp[2 * 68], sp[3 * 68]); o.z = cvt_pk_bf16(sp[4 * 68], sp[5 * 68]); o.w = cvt_pk_bf16(sp[6 * 68], sp[7 * 68]);
        *(u32x4*)(WT + (size_t)(dst_row0 + n) * K + k0 + 8 * c) = o; }
    LDS_WAIT(); asm volatile("" ::: "memory");
}
__device__ __forceinline__ void p0_convert_item(const float* W, int N, bf16_t* Wb, const float* gk, int k0, int n0, int lane) {
    f32x4 v[16];
#pragma unroll
    for (int i = 0; i < 16; ++i) { const int kk = 4 * i + (lane >> 4); v[i] = *(const f32x4*)(W + (size_t)(k0 + kk) * N + n0 + 4 * (lane & 15)); }
#pragma unroll
    for (int i = 0; i < 16; ++i) { const int kk = 4 * i + (lane >> 4); const f32x4 y = v[i] * gk[k0 + kk];
        u32x2 o; o.x = cvt_pk_bf16(y[0], y[1]); o.y = cvt_pk_bf16(y[2], y[3]); *(u32x2*)(Wb + (size_t)(k0 + kk) * N + n0 + 4 * (lane & 15)) = o; }
}
template <bool SWIGLU>
__device__ __forceinline__ bool p0_matrix(int& r, const float* W, int K, int N, bf16_t* WT, const float* gk, LAS float* scr, int lane) {
    const int nblk = N / 64, items = (K / 64) * nblk;
    if (r >= items) { r -= items; return false; }
    const int kb = r / nblk, nb = r % nblk, n0 = 64 * nb; int dst0 = n0;
    if (SWIGLU) { const int bj = n0 >= DFF ? 1 : 0, j = n0 - bj * DFF; dst0 = 256 * (j >> 7) + 128 * bj + (j & 127); }
    p0_transpose_item(W, K, N, WT, dst0, gk, scr, 64 * kb, n0, lane);
    return true;
}
template <int MAT>
__device__ __forceinline__ bool conv_mat(int& r, const Args& a, int l, LAS float* scr, int lane) {
    unsigned char* wl = a.ws + WS_W + (size_t)l * W_LAYER;
    if (MAT == 0) return p0_matrix<true>(r, a.in[3] + (size_t)l * D * 2 * DFF, D, 2 * DFF, (bf16_t*)(wl + W_1IN), a.in[2] + l * D, scr, lane);
    if (MAT == 1) return p0_matrix<false>(r, a.in[4] + (size_t)l * DFF * D, DFF, D, (bf16_t*)(wl + W_1OUT), nullptr, scr, lane);
    if (MAT == 2) return p0_matrix<false>(r, a.in[6] + (size_t)l * D * DZ, D, DZ, (bf16_t*)(wl + W_MIXIN), a.in[5] + l * D, scr, lane);
    if (MAT == 3) return p0_matrix<false>(r, a.in[16] + (size_t)l * D * D, D, D, (bf16_t*)(wl + W_MIXOUT), nullptr, scr, lane);
    if (MAT == 4) { if (r >= 256) { r -= 256; return false; } p0_convert_item(a.in[19] + (size_t)l * D * D, D, (bf16_t*)(wl + W_Q), a.in[17] + l * D, 64 * (r / 16), 64 * (r % 16), lane); return true; }
    if (MAT == 5) return p0_matrix<false>(r, a.in[20] + (size_t)l * D * 2 * D, D, 2 * D, (bf16_t*)(wl + W_KV), nullptr, scr, lane);
    if (MAT == 6) return p0_matrix<false>(r, a.in[21] + (size_t)l * D * D, D, D, (bf16_t*)(wl + W_O), nullptr, scr, lane);
    if (MAT == 7) return p0_matrix<true>(r, a.in[23] + (size_t)l * D * 2 * DFF, D, 2 * DFF, (bf16_t*)(wl + W_2IN), a.in[22] + l * D, scr, lane);
    return p0_matrix<false>(r, a.in[24] + (size_t)l * DFF * D, DFF, D, (bf16_t*)(wl + W_2OUT), nullptr, scr, lane);
}
template <int GROUP>
__device__ __forceinline__ void convert_group(const Args& a, LAS unsigned char* lds, int gwx, int ngwx, int wave, int lane_in) {
    int lane = lane_in; asm volatile("" : "+v"(lane));
    LAS float* scr = (LAS float*)(lds + wave * 17408);
    constexpr int TOTAL = GROUP == 0 ? 1408 + 512 + 704 + 512 : GROUP == 1 ? 256 + 256 + 256 + 1408 + 512 : GROUP == 2 ? 704 + 1408 + 704 + 512 + 256 + 256 + 256 : 1408 + 704;
    for (int it = gwx; it < TOTAL; it += ngwx) {
        int r = it;
        if (GROUP == 0) { if (conv_mat<0>(r, a, 0, scr, lane)) continue; if (conv_mat<5>(r, a, 0, scr, lane)) continue; if (conv_mat<1>(r, a, 0, scr, lane)) continue; conv_mat<2>(r, a, 0, scr, lane); }
        if (GROUP == 1) { if (conv_mat<3>(r, a, 0, scr, lane)) continue; if (conv_mat<4>(r, a, 0, scr, lane)) continue;
                          if (conv_mat<6>(r, a, 0, scr, lane)) continue; if (conv_mat<7>(r, a, 0, scr, lane)) continue; conv_mat<5>(r, a, 1, scr, lane); }
        if (GROUP == 2) { if (conv_mat<8>(r, a, 0, scr, lane)) continue; if (conv_mat<0>(r, a, 1, scr, lane)) continue; if (conv_mat<1>(r, a, 1, scr, lane)) continue; if (conv_mat<2>(r, a, 1, scr, lane)) continue;
                          if (conv_mat<3>(r, a, 1, scr, lane)) continue; if (conv_mat<4>(r, a, 1, scr, lane)) continue; conv_mat<6>(r, a, 1, scr, lane); }
        if (GROUP == 3) { if (conv_mat<7>(r, a, 1, scr, lane)) continue; conv_mat<8>(r, a, 1, scr, lane); }
    }
}
__device__ __forceinline__ void p0_prologue(const Args& a, LAS unsigned char* lds, int gw, int NGW, int wave, int lane) {
    unsigned char* ws = a.ws;
    convert_group<0>(a, lds, gw, NGW, wave, lane);
    bf16_t* XB = (bf16_t*)(ws + WS_XB); float* SS = (float*)(ws + WS_SS);
    for (int m = gw; m < M; m += NGW) {
        const f32x4* xr = (const f32x4*)(a.in[0] + (size_t)m * D) + lane; float s = 0.f;
        unsigned long long* o8 = (unsigned long long*)(XB + (size_t)m * D) + lane;
#pragma unroll
        for (int j = 0; j < 4; ++j) { const f32x4 v = xr[64 * j]; s += (v[0] * v[0] + v[1] * v[1]) + (v[2] * v[2] + v[3] * v[3]);
            o8[64 * j] = (unsigned long long)cvt_pk_bf16(v[0], v[1]) | ((unsigned long long)cvt_pk_bf16(v[2], v[3]) << 32); }
        s = wave_sum(s);
        if (lane < 4) SS[(size_t)m * 4 + lane] = lane == 0 ? s : 0.f;
    }
    for (int m = gw; m < 2 * BATCH * NMEM; m += NGW) {
        const int l = m / (BATCH * NMEM), rr = m % (BATCH * NMEM);
        const f32x4* xr = (const f32x4*)(a.in[1] + (size_t)rr * D) + lane; const f32x4* gr = (const f32x4*)(a.in[18] + l * D) + lane; f32x4 v[4]; float s = 0.f;
#pragma unroll
        for (int j = 0; j < 4; ++j) { v[j] = xr[64 * j]; s += (v[j][0] * v[j][0] + v[j][1] * v[j][1]) + (v[j][2] * v[j][2] + v[j][3] * v[j][3]); }
        const float rs = 1.0f / sqrtf(wave_sum(s) * (1.0f / D) + 1e-6f);
        unsigned long long* o8 = (unsigned long long*)((bf16_t*)(ws + WS_MEMN) + (size_t)m * D) + lane;
#pragma unroll
        for (int j = 0; j < 4; ++j) { const f32x4 g = gr[64 * j]; const f32x4 y = v[j] * rs * g;
            o8[64 * j] = (unsigned long long)cvt_pk_bf16(y[0], y[1]) | ((unsigned long long)cvt_pk_bf16(y[2], y[3]) << 32); }
    }
}

__device__ __forceinline__ f32x4 bf4_lo(const u32x4 u) { return (f32x4){bf_lo(u.x), bf_hi(u.x), bf_lo(u.y), bf_hi(u.y)}; }
__device__ __forceinline__ f32x4 bf4_hi(const u32x4 u) { return (f32x4){bf_lo(u.z), bf_hi(u.z), bf_lo(u.w), bf_hi(u.w)}; }
__device__ __forceinline__ void mixer_a(const bf16_t* Z, bf16_t* Y, const float* sw, int ch, int tid) {
    const int m0 = ch * 128, t0 = m0 & (SEQ - 1);
    const int cg8 = tid & 31, c = 8 * cg8;
    const f32x4 w0l = *(const f32x4*)(sw + c), w0h = *(const f32x4*)(sw + c + 4), w1l = *(const f32x4*)(sw + 256 + c), w1h = *(const f32x4*)(sw + 256 + c + 4), w2l = *(const f32x4*)(sw + 512 + c), w2h = *(const f32x4*)(sw + 512 + c + 4);
#pragma unroll 4
    for (int it = 0; it < 8; ++it) {
        const int tl = (tid >> 5) + 16 * it, tpos = t0 + tl; const bf16_t* zr = Z + (size_t)(m0 + tl) * ZS + c;
        const u32x4 zero = (u32x4){0u, 0u, 0u, 0u};
        const u32x4 ub = *(const u32x4*)zr, uc0 = *(const u32x4*)(zr + 256), ux0 = *(const u32x4*)(zr + 512);
        u32x4 uc1 = *(const u32x4*)(zr - ZS + 256), ux1 = *(const u32x4*)(zr - ZS + 512);
        u32x4 uc2 = *(const u32x4*)(zr - 2 * ZS + 256), ux2 = *(const u32x4*)(zr - 2 * ZS + 512);
        if (tpos < 1) uc1 = zero; if (tpos < 2) uc2 = zero;
        const f32x4 yl = bf4_lo(ub) * (w0l * (bf4_lo(uc2) * bf4_lo(ux2)) + w1l * (bf4_lo(uc1) * bf4_lo(ux1)) + w2l * (bf4_lo(uc0) * bf4_lo(ux0)));
        const f32x4 yh = bf4_hi(ub) * (w0h * (bf4_hi(uc2) * bf4_hi(ux2)) + w1h * (bf4_hi(uc1) * bf4_hi(ux1)) + w2h * (bf4_hi(uc0) * bf4_hi(ux0)));
        u32x4 o; o.x = cvt_pk_bf16(yl[0], yl[1]); o.y = cvt_pk_bf16(yl[2], yl[3]); o.z = cvt_pk_bf16(yh[0], yh[1]); o.w = cvt_pk_bf16(yh[2], yh[3]);
        *(u32x4*)(Y + (size_t)(m0 + tl) * YS + c) = o;
    }
}
__device__ __forceinline__ void mixer_d(const bf16_t* Z, bf16_t* Y, const float* pw, const float* pscale, LAS unsigned char* lds, int hd, int tid) {
    constexpr int PS = 264;
    LAS bf16_t* WT = (LAS bf16_t*)lds;
    LAS bf16_t* PL = (LAS bf16_t*)(lds + 40960);
    const int m0 = hd * 64, t0 = m0 & (SEQ - 1);
    u32x4 wfr[2][4]; f32x4 scv[4];
    { const int lane = tid & 63, fr = lane & 15, fq = lane >> 4, g = (tid >> 6) >> 1;
#pragma unroll
      for (int ks = 0; ks < 2; ++ks)
#pragma unroll
        for (int nt = 0; nt < 4; ++nt) { const float* wp = pw + ((size_t)g * 64 + 32 * ks + 8 * fq) * 64 + 16 * nt + fr;
            wfr[ks][nt].x = cvt_pk_bf16(wp[0], wp[64]); wfr[ks][nt].y = cvt_pk_bf16(wp[128], wp[192]); wfr[ks][nt].z = cvt_pk_bf16(wp[256], wp[320]); wfr[ks][nt].w = cvt_pk_bf16(wp[384], wp[448]); }
#pragma unroll
      for (int nt = 0; nt < 4; ++nt) scv[nt] = *(const f32x4*)(pscale + g * 64 + 16 * nt + 4 * fq); }
#pragma unroll
    for (int it = 0; it < 5; ++it) { const int idx = tid + NTHR * it; const int r = idx >> 5, cg8 = idx & 31;
            u32x4 v = *(const u32x4*)(Z + (size_t)(m0 - 15 + r) * ZS + 1792 + 8 * cg8); if (t0 - 15 + r < 0) v = (u32x4){0u, 0u, 0u, 0u};
            *(LAS u32x4*)(WT + r * 256 + 8 * cg8) = v; }
    __syncthreads();
    {
        const int cp = tid & 127, tg = tid >> 7, c = 2 * cp, k = 2 << (c >> 6);
        const int r0 = 15 + 16 * tg, tpos = t0 + 16 * tg;
        float sa = 0.f, sb = 0.f;
        for (int j = 1; j < k; ++j) { const unsigned u = *(const LAS unsigned*)(WT + (r0 - j) * 256 + c); sa += bf_lo(u); sb += bf_hi(u); }
#pragma unroll 4
        for (int i = 0; i < 16; ++i) {
            const unsigned u = *(const LAS unsigned*)(WT + (r0 + i) * 256 + c); const float wa = bf_lo(u), wb = bf_hi(u);
            sa += wa; sb += wb;
            const int cnt = (tpos + i + 1 < k) ? (tpos + i + 1) : k; const float inv = 1.0f / (float)cnt;
            *(LAS unsigned*)(PL + (16 * tg + i) * PS + c) = cvt_pk_bf16(sa * inv - wa, sb * inv - wb);
            const unsigned u2 = *(const LAS unsigned*)(WT + (r0 + i - (k - 1)) * 256 + c); sa -= bf_lo(u2); sb -= bf_hi(u2);
        }
    }
    __syncthreads();
    {
        const int wave = tid >> 6, lane = tid & 63, fr = lane & 15, fq = lane >> 4, g = wave >> 1, th = wave & 1;
        f32x4 acc[2][4];
#pragma unroll
        for (int mt = 0; mt < 2; ++mt)
#pragma unroll
            for (int nt = 0; nt < 4; ++nt) acc[mt][nt] = (f32x4){0.f, 0.f, 0.f, 0.f};
#pragma unroll
        for (int ks = 0; ks < 2; ++ks) {
            bf16x8 pf[2];
#pragma unroll
            for (int mt = 0; mt < 2; ++mt) pf[mt] = *(const LAS bf16x8*)(PL + (32 * th + 16 * mt + fr) * PS + g * 64 + 32 * ks + 8 * fq);
#pragma unroll
            for (int nt = 0; nt < 4; ++nt) { const bf16x8 wf = __builtin_bit_cast(bf16x8, wfr[ks][nt]);
#pragma unroll
                for (int mt = 0; mt < 2; ++mt) acc[mt][nt] = __builtin_amdgcn_mfma_f32_16x16x32_bf16(wf, pf[mt], acc[mt][nt], 0, 0, 0); }
        }
#pragma unroll
        for (int nt = 0; nt < 4; ++nt) { const int d0 = g * 64 + 16 * nt + 4 * fq; const f32x4 sc = scv[nt];
#pragma unroll
            for (int mt = 0; mt < 2; ++mt) { const int t = 32 * th + 16 * mt + fr; const f32x4 y = acc[mt][nt] * sc;
                u32x2 o; o.x = cvt_pk_bf16(y[0], y[1]); o.y = cvt_pk_bf16(y[2], y[3]);
                *(u32x2*)(Y + (size_t)(m0 + t) * YS + 768 + d0) = o; } }
    }
    __syncthreads();
}
__device__ __forceinline__ void mixer_c(const bf16_t* Z, bf16_t* Y, const float* cw, const float* lng, const float* lnb, LAS unsigned char* lds, int hc, int tid) {
    LAS float* GL = (LAS float*)lds;
    const int m0 = hc * 64, t0 = m0 & (SEQ - 1);
    const int c = tid & 255;
    float w[31];
#pragma unroll
    for (int k = 0; k < 31; ++k) w[k] = cw[k * 256 + c];
    const f32x4 g4 = *(const f32x4*)(lng + 4 * (tid & 63)), b4 = *(const f32x4*)(lnb + 4 * (tid & 63));
#pragma unroll
    for (int it = 0; it < 6; ++it) { const int idx = tid + NTHR * it; const int r = idx >> 5, cg8 = idx & 31;
            const bf16_t* zr = Z + (size_t)(m0 - 30 + r) * ZS + 8 * cg8; const u32x4 ua = *(const u32x4*)(zr + 1280), ug = *(const u32x4*)(zr + 1536);
            const f32x4 al = bf4_lo(ua), ah = bf4_hi(ua), sl = bf4_lo(ug), sh = bf4_hi(ug); f32x4 gl, gh;
#pragma unroll
            for (int e = 0; e < 4; ++e) { gl[e] = al[e] * __builtin_amdgcn_rcpf(1.0f + __expf(-sl[e])); gh[e] = ah[e] * __builtin_amdgcn_rcpf(1.0f + __expf(-sh[e])); }
            if (t0 - 30 + r < 0) { gl = (f32x4){0.f, 0.f, 0.f, 0.f}; gh = gl; }
            *(LAS f32x4*)(GL + r * 256 + 8 * cg8) = gl; *(LAS f32x4*)(GL + r * 256 + 8 * cg8 + 4) = gh; }
    __syncthreads();
    float outv[2][16];
    {
#pragma unroll
        for (int it = 0; it < 2; ++it) { const int tg = (tid >> 8) + 2 * it; float gv[46];
#pragma unroll
            for (int j = 0; j < 46; ++j) gv[j] = GL[(16 * tg + j) * 256 + c];
#pragma unroll
            for (int j = 0; j < 16; ++j) { float acc = 0.f;
#pragma unroll
                for (int k = 0; k < 31; ++k) acc += w[k] * gv[j + k];
                outv[it][j] = acc; } }
    }
    __syncthreads();
#pragma unroll
    for (int it = 0; it < 2; ++it) { const int tg = (tid >> 8) + 2 * it;
#pragma unroll
        for (int j = 0; j < 16; ++j) GL[(16 * tg + j) * 256 + c] = outv[it][j]; }
    __syncthreads();
    {
        const int wave = tid >> 6, lane = tid & 63;
#pragma unroll
        for (int i = 0; i < 8; ++i) { const int tt = wave * 8 + i; f32x4 v = *(const LAS f32x4*)(GL + tt * 256 + 4 * lane);
            const float mu = wave_sum((v[0] + v[1]) + (v[2] + v[3])) * (1.0f / 256.0f); v = v - mu;
            const float var = wave_sum((v[0] * v[0] + v[1] * v[1]) + (v[2] * v[2] + v[3] * v[3])) * (1.0f / 256.0f);
            const float rs = 1.0f / sqrtf(var + 1e-6f); f32x4 y = v * rs * g4 + b4;
            y[0] = pg8::fast_silu(y[0]); y[1] = pg8::fast_silu(y[1]); y[2] = pg8::fast_silu(y[2]); y[3] = pg8::fast_silu(y[3]);
            u32x2 o; o.x = cvt_pk_bf16(y[0], y[1]); o.y = cvt_pk_bf16(y[2], y[3]);
            *(u32x2*)(Y + (size_t)(m0 + tt) * YS + 512 + 4 * lane) = o; }
    }
    __syncthreads();
}
__device__ __forceinline__ void mixer_b(const bf16_t* Z, bf16_t* Y, const float* ng, const float* wsg, const float* bs, LAS unsigned char* lds, int ch, int tid) {
    constexpr int VS = 136;
    LAS bf16_t* VT = (LAS bf16_t*)lds;
    const int m0 = ch * 128, wave = tid >> 6, lane = tid & 63, fr = lane & 15, fq = lane >> 4;
    {
        const f32x4 g4 = *(const f32x4*)(ng + 4 * lane);
        unsigned pk[4][8];
#pragma unroll
        for (int j2 = 0; j2 < 8; ++j2) { float y[2][4];
#pragma unroll
            for (int e = 0; e < 2; ++e) { const int s = 16 * wave + 2 * j2 + e; const u32x2 u = *(const u32x2*)(Z + (size_t)(m0 + s) * ZS + 1024 + 4 * lane);
                f32x4 v = (f32x4){bf_lo(u.x), bf_hi(u.x), bf_lo(u.y), bf_hi(u.y)};
                const float mu = wave_sum((v[0] + v[1]) + (v[2] + v[3])) * (1.0f / 256.0f); v = v - mu;
                const float var = wave_sum((v[0] * v[0] + v[1] * v[1]) + (v[2] * v[2] + v[3] * v[3])) * (1.0f / 256.0f);
                const float rs = 1.0f / sqrtf(var + 1e-6f); const f32x4 o = v * rs * g4;
                y[e][0] = o[0]; y[e][1] = o[1]; y[e][2] = o[2]; y[e][3] = o[3]; }
#pragma unroll
            for (int i = 0; i < 4; ++i) pk[i][j2] = cvt_pk_bf16(y[0][i], y[1][i]); }
#pragma unroll
        for (int i = 0; i < 4; ++i) { LAS u32x4* dst = (LAS u32x4*)(VT + (4 * lane + i) * VS + 16 * wave);
            dst[0] = (u32x4){pk[i][0], pk[i][1], pk[i][2], pk[i][3]}; dst[1] = (u32x4){pk[i][4], pk[i][5], pk[i][6], pk[i][7]}; }
    }
    u32x2 ug[4][4]; float biasv[4];
    { const int h = wave >> 1, th = wave & 1;
#pragma unroll
      for (int mt = 0; mt < 4; ++mt) { const int t = 64 * th + 16 * mt + fr; biasv[mt] = bs[h * 128 + t];
#pragma unroll
        for (int nt = 0; nt < 4; ++nt) ug[mt][nt] = *(const u32x2*)(Z + (size_t)(m0 + t) * ZS + 768 + h * 64 + 16 * nt + 4 * fq); } }
    __syncthreads();
    {
        const int h = wave >> 1, th = wave & 1;
        f32x4 acc[4][4];
#pragma unroll
        for (int mt = 0; mt < 4; ++mt)
#pragma unroll
            for (int nt = 0; nt < 4; ++nt) acc[mt][nt] = (f32x4){0.f, 0.f, 0.f, 0.f};
#pragma unroll
        for (int ks = 0; ks < 4; ++ks) {
            if (32 * ks > 64 * th + 63) continue;
            bf16x8 bfr[4];
#pragma unroll
            for (int nt = 0; nt < 4; ++nt) bfr[nt] = *(const LAS bf16x8*)(VT + (h * 64 + 16 * nt + fr) * VS + 32 * ks + 8 * fq);
#pragma unroll
            for (int mt = 0; mt < 4; ++mt) { const int t = 64 * th + 16 * mt + fr, s = 32 * ks + 8 * fq;
                const f32x4* wp = (const f32x4*)(wsg + ((size_t)h * 128 + t) * 128 + s); f32x4 w0 = wp[0], w1 = wp[1];
#pragma unroll
                for (int e = 0; e < 4; ++e) { if (s + e > t) w0[e] = 0.f; if (s + 4 + e > t) w1[e] = 0.f; }
                u32x4 au; au.x = cvt_pk_bf16(w0[0], w0[1]); au.y = cvt_pk_bf16(w0[2], w0[3]); au.z = cvt_pk_bf16(w1[0], w1[1]); au.w = cvt_pk_bf16(w1[2], w1[3]);
                const bf16x8 afr = __builtin_bit_cast(bf16x8, au);
#pragma unroll
                for (int nt = 0; nt < 4; ++nt) acc[mt][nt] = __builtin_amdgcn_mfma_f32_16x16x32_bf16(bfr[nt], afr, acc[mt][nt], 0, 0, 0); }
        }
#pragma unroll
        for (int mt = 0; mt < 4; ++mt) { const int t = 64 * th + 16 * mt + fr; const float bias = biasv[mt];
#pragma unroll
            for (int nt = 0; nt < 4; ++nt) { const int d0 = h * 64 + 16 * nt + 4 * fq; const u32x2 u = ug[mt][nt];
                const f32x4 a = acc[mt][nt]; u32x2 o; o.x = cvt_pk_bf16(bf_lo(u.x) * (a[0] + bias), bf_hi(u.x) * (a[1] + bias)); o.y = cvt_pk_bf16(bf_lo(u.y) * (a[2] + bias), bf_hi(u.y) * (a[3] + bias));
                *(u32x2*)(Y + (size_t)(m0 + t) * YS + 256 + d0) = o; } }
    }
    __syncthreads();
}

template <class Sched>
__device__ __forceinline__ int build_rs_table(const float* ss, const Sched& S, LAS unsigned char* lds, int tid_in) {
    int tid = tid_in; asm volatile("" : "+v"(tid));
    pg8::Unit u0; int pm = -1;
    if (S.next(0, u0)) { pm = u0.pm; if (tid < 256) ((LAS float*)(lds + RING_BYTES + 4096))[tid] = pg8::row_rs(ss, pm * 256 + tid); }
    __syncthreads();
    return pm;
}
__device__ __forceinline__ void kv_gemm(LAS unsigned char* lds, unsigned char* ws, int ll, int G, int c2) {
    const bf16_t* memn = (const bf16_t*)(ws + WS_MEMN) + (size_t)ll * 1024 * D; const bf16_t* wkv = (const bf16_t*)(ws + WS_W + (size_t)ll * W_LAYER + W_KV);
    pg8::StaticOrder S; S.init(1024, 2048, G, c2);
    pg8::Gemm g = pg8::plain_gemm(memn, wkv, D); pg8::EpiBf16 E{(bf16_t*)(ws + WS_KB) + (size_t)ll * 1024 * 2048, 2048, nullptr, 1.0f, -1};
    pg8::gemm_phase<pg8::EpiBf16, pg8::StaticOrder, true>(lds, g, S, E);
}
__device__ __forceinline__ void vwo_gemm(LAS unsigned char* lds, unsigned char* ws, int ll, int b, int G, int c2) {
    pg8::Gemm g; g.A = (const bf16_t*)(ws + WS_W + (size_t)ll * W_LAYER + W_O); g.Bt = (const bf16_t*)(ws + WS_KB) + (size_t)ll * 1024 * 2048 + (size_t)b * 256 * 2048 + 1024;
    g.lda = 1024; g.ldb = 2048; g.K = 256; g.a_pm = 256L * 1024; g.a_pn = 256; g.b_pn = 256; g.b_pb = 0; g.b_pm = 0;
    pg8::StaticOrder S; S.init(1024, 1024, G, c2);
    pg8::EpiBf16 E{(bf16_t*)(ws + WS_VWO) + (size_t)b * 1024 * 1024, 1024, nullptr, 1.0f, -1};
    pg8::gemm_phase<pg8::EpiBf16, pg8::StaticOrder, true>(lds, g, S, E);
}

__device__ __forceinline__ void kq_gemm(LAS unsigned char* lds, unsigned char* ws, int ll, int b, int G, int c2) {
    pg8::Gemm g; g.A = (const bf16_t*)(ws + WS_KB) + (size_t)ll * 1024 * 2048 + (size_t)b * 256 * 2048; g.Bt = (const bf16_t*)(ws + WS_W + (size_t)ll * W_LAYER + W_Q);
    g.lda = 2048; g.ldb = 1024; g.K = 256; g.a_pm = 256; g.a_pn = 0; g.b_pn = 256L * 1024; g.b_pb = 0; g.b_pm = 256;
    pg8::StaticOrder S; S.init(1024, 1024, G, c2);
    pg8::EpiBf16 E{(bf16_t*)(ws + WS_KQ) + (size_t)b * 1024 * 1024, 1024, nullptr, 1.0f, -1};
    pg8::gemm_phase<pg8::EpiBf16, pg8::StaticOrder, true>(lds, g, S, E);
}

__global__ void __launch_bounds__(NTHR, 2) mk_fwd(Args args) {
    extern __shared__ __attribute__((aligned(16))) unsigned char lds_raw[];
    LAS unsigned char* lds = (LAS unsigned char*)lds_raw;
    const int tid = threadIdx.x, lane = tid & 63, wave = __builtin_amdgcn_readfirstlane(tid >> 6);
    const int G = gridDim.x, bx0 = blockIdx.x;
    const int gw = bx0 * NWAVES + wave, NGW = G * NWAVES;
    unsigned char* ws = args.ws;
    float* X = args.out;
    bf16_t* XB = (bf16_t*)(ws + WS_XB); float* SS = (float*)(ws + WS_SS);
    bf16_t* ACT = (bf16_t*)(ws + WS_R); bf16_t* Zb = ACT; bf16_t* Yb = ACT + 2048;
    bf16_t* Pb = ACT;
    const int lo = args.ph_lo, hi = args.ph_hi;
    cg::grid_group grid = cg::this_grid();
    volatile LAS unsigned* bst = (volatile LAS unsigned*)(lds + RING_BYTES + 8192);
    if (tid < 4) bst[tid] = 0u;
    __syncthreads();
    XcdBarrier xbar; xbar.bar = (unsigned*)(ws + WS_CTL); xbar.x = 0; xbar.st = bst;
    if (hi - lo > 1) xbar = xcd_barrier_post((unsigned*)(ws + WS_CTL), bst);
    const bool fuse_final = (lo == 0 && hi == NPH && G == 256);
    if (lo < 0) grid.sync();
#define IN(k) (lo <= (k) && (k) < hi)
#define SEAMF(k, f) do { if (IN(k) && IN((k) + 1)) { xcd_barrier(xbar, (f) || !loc); if (PROBE_MASK & (1 << 10)) xcd_barrier(xbar); } } while (0)
#define SEAM(k) SEAMF(k, true)
#define SEAML(k) do { if (IN(k) && IN((k) + 1)) { if (gcnt) group_barrier(gcnt); else xcd_barrier(xbar, true, false); if (PROBE_MASK & (1 << 10)) xcd_barrier(xbar); } } while (0)
#define WG_SEAM() do { asm volatile("s_waitcnt vmcnt(0)" ::: "memory"); __syncthreads(); } while (0)
#define REP(cls) for (int rep_ = 0; rep_ < ((PROBE_MASK >> (cls)) & 1) + 1; ++rep_)

    bool loc = false;
    if (IN(0)) REP(0) p0_prologue(args, lds, gw, NGW, wave, lane);
    SEAM(0);
    int bx = bx0;
    if (IN(0) && IN(1) && bst[2] != 0u) { bx = (int)(bst[3] * 8u + xbar.x); loc = true; }
    bx = __builtin_amdgcn_readfirstlane(bx);
    unsigned* gcnt = loc ? (unsigned*)(ws + WS_CTL) + 8192 + 64 * (bx & 63) : nullptr;
    if ((PROBE_MASK & (1 << 12)) && IN(0) && IN(1) && !loc) { for (int i_ = 0; i_ < 20; ++i_) xcd_barrier(xbar); }
#pragma unroll 1
    for (int l = 0; l < 2; ++l) {
        const int pb = 1 + 11 * l;
        unsigned char* wl = ws + WS_W + (size_t)l * W_LAYER;
        if (IN(pb + 0)) {
            REP(1) { pg8::Gemm g = pg8::plain_gemm(XB, (const bf16_t*)(wl + W_1IN), D); pg8::StaticOrder S; S.init(M, 2 * DFF, G, bx);
              pg8::EpiSwiGLU E{ACT, SS, build_rs_table(SS, S, lds, tid)}; pg8::gemm_phase<pg8::EpiSwiGLU, pg8::StaticOrder, true>(lds, g, S, E); }
            __syncthreads();
            if (l == 0) {
                kv_gemm(lds, ws, 0, G, (bx + 2 * G - 128) % G);
                if (bx >= 160) convert_group<1>(args, lds, (bx - 160) * NWAVES + wave, (G - 160) * NWAVES, wave, lane);
            } else { if (bx >= 128) convert_group<3>(args, lds, (bx - 128) * NWAVES + wave, (G - 128) * NWAVES, wave, lane); }
        }
        SEAML(pb + 0);
        if (IN(pb + 1)) REP(2) { pg8::Gemm g = pg8::plain_gemm(ACT, (const bf16_t*)(wl + W_1OUT), DFF); g.lda = LDR; g.a_pm = 256L * LDR; pg8::StaticOrder S; S.init(M, D, G, bx);
            pg8::EpiResid E{XB, SS, rep_ == 0 ? 0.5f : 0.f}; pg8::gemm_phase<pg8::EpiResid, pg8::StaticOrder, false>(lds, g, S, E); }
        SEAML(pb + 1);
        if (IN(pb + 2)) REP(3) { pg8::Gemm g = pg8::plain_gemm(XB, (const bf16_t*)(wl + W_MIXIN), D); pg8::StaticOrder S; S.init(M, DZ, G, bx);
            pg8::EpiBf16 E{Zb, ZS, SS, 1.0f, build_rs_table(SS, S, lds, tid)}; pg8::gemm_phase<pg8::EpiBf16, pg8::StaticOrder, true>(lds, g, S, E); }
        SEAM(pb + 2);
        if (IN(pb + 3)) REP(4) {
            for (int u = bx; u < 768; u += G) {
                int ptid = tid; asm volatile("" : "+v"(ptid));
                if (u < 256) mixer_c(Zb, Yb, args.in[11] + l * 31 * 256, args.in[12] + l * 256, args.in[13] + l * 256, lds, u, ptid);
                else if (u < 512) mixer_d(Zb, Yb, args.in[14] + (size_t)l * 4 * 64 * 64, args.in[15] + l * 256, lds, u - 256, ptid);
                else if (u < 640) mixer_b(Zb, Yb, args.in[8] + l * 256, args.in[9] + (size_t)l * 4 * 128 * 128, args.in[10] + l * 4 * 128, lds, u - 512, ptid);
                else mixer_a(Zb, Yb, args.in[7] + l * 3 * 256, u - 640, ptid);
            }
            for (int b = 0; b < 4; ++b) vwo_gemm(lds, ws, l, b, G, (bx + 2 * G - 192 - 16 * b) % G);
            for (int b = 0; b < 4; ++b) kq_gemm(lds, ws, l, b, G, (bx + 2 * G - 128 - 16 * b) % G);
        }
        SEAM(pb + 3);
        if (IN(pb + 4)) REP(5) { pg8::Gemm g = pg8::plain_gemm(Yb, (const bf16_t*)(wl + W_MIXOUT), D); g.lda = LDR; g.a_pm = 256L * LDR; if (PROBE_K2 && rep_ == 1) g.K = PROBE_K2;
            pg8::StaticOrder S; S.init(M, D, G, bx);
            pg8::EpiResid E{XB, SS, rep_ == 0 ? 1.0f : 0.f}; pg8::gemm_phase<pg8::EpiResid, pg8::StaticOrder, false>(lds, g, S, E); }
        SEAML(pb + 4);
        if (IN(pb + 5)) REP(6) { pg8::Gemm g = pg8::plain_gemm(XB, (const bf16_t*)(ws + WS_KQ), D); g.b_pb = 1024L * 1024; pg8::StaticOrder S; S.init(M, D, G, bx);
            pg8::EpiSoftmax E{Pb, SS, QSCALE, build_rs_table(SS, S, lds, tid)}; pg8::gemm_phase<pg8::EpiSoftmax, pg8::StaticOrder, false>(lds, g, S, E); }
        SEAML(pb + 7);
        if (IN(pb + 8)) REP(9) { pg8::Gemm g = pg8::plain_gemm(Pb, (const bf16_t*)(ws + WS_VWO), D); g.b_pb = 1024L * 1024; g.lda = LDR; g.a_pm = 256L * LDR; pg8::StaticOrder S; S.init(M, D, G, bx);
            pg8::EpiResid E{XB, SS, rep_ == 0 ? 1.0f : 0.f}; pg8::gemm_phase<pg8::EpiResid, pg8::StaticOrder, false>(lds, g, S, E); }
        SEAML(pb + 8);
        if (IN(pb + 9)) {
            REP(1) { pg8::Gemm g = pg8::plain_gemm(XB, (const bf16_t*)(wl + W_2IN), D); pg8::StaticOrder S; S.init(M, 2 * DFF, G, bx);
            pg8::EpiSwiGLU E{ACT, SS, build_rs_table(SS, S, lds, tid)}; pg8::gemm_phase<pg8::EpiSwiGLU, pg8::StaticOrder, true>(lds, g, S, E); }
            __syncthreads();
            if (l == 0) {
                kv_gemm(lds, ws, 1, G, (bx + 2 * G - 128) % G);
                if (bx >= 160) convert_group<2>(args, lds, (bx - 160) * NWAVES + wave, (G - 160) * NWAVES, wave, lane);
            } }
        if (l == 0) SEAMF(pb + 9, true); else SEAML(pb + 9);
        if (IN(pb + 10)) {
            if (l == 1 && fuse_final) {
                pg8::Gemm g = pg8::plain_gemm(ACT, (const bf16_t*)(wl + W_2OUT), DFF); g.lda = LDR; g.a_pm = 256L * LDR; pg8::StaticOrder S; S.init(M, D, G, bx);
                EpiFinal E{XB, SS, args.in[25], X, 0.5f, xbar, !loc, gcnt}; pg8::gemm_phase<EpiFinal, pg8::StaticOrder, false>(lds, g, S, E);
            } else REP(2) { pg8::Gemm g = pg8::plain_gemm(ACT, (const bf16_t*)(wl + W_2OUT), DFF); g.lda = LDR; g.a_pm = 256L * LDR; pg8::StaticOrder S; S.init(M, D, G, bx);
                pg8::EpiResid E{XB, SS, rep_ == 0 ? 0.5f : 0.f}; pg8::gemm_phase<pg8::EpiResid, pg8::StaticOrder, false>(lds, g, S, E); } }
        if (l == 0) SEAML(pb + 10); else if (!fuse_final) SEAMF(pb + 10, true);
    }
    if (IN(23) && !fuse_final) REP(11) {
        const f32x4* gf = (const f32x4*)args.in[25] + lane;
        for (int m = gw; m < M; m += NGW) { const float rs = pg8::row_rs(SS, m); const u32x2* xr = (const u32x2*)(XB + (size_t)m * D) + lane; f32x4* orow = (f32x4*)(X + (size_t)m * D) + lane;
#pragma unroll
            for (int j = 0; j < 4; ++j) { const u32x2 u = xr[64 * j]; const f32x4 v = (f32x4){bf_lo(u.x), bf_hi(u.x), bf_lo(u.y), bf_hi(u.y)};
                orow[64 * j] = v * rs * gf[64 * j]; } }
    }
#undef IN
#undef SEAM
#undef SEAML
#undef REP
#undef WG_SEAM
}
}
#define MK_MODE 0

#ifndef MK_MODE
#define MK_MODE 0
#endif
extern "C" void kernel_launch(void* const* d_in, const int* in_sizes, int n_in, void* d_out, int out_size, void* d_ws, size_t ws_size, hipStream_t stream) {
    using namespace mk;
    static int grid = 0;
    if (grid == 0) {
        if (n_in != 26 || out_size != M * D || ws_size < WS_END) { fprintf(stderr, "kernel_launch: unexpected shapes (n_in %d out %d ws %zu)\n", n_in, out_size, ws_size); grid = -1; return; }
        int dev = 0, cus = 0, per_cu = 0;
        hipGetDevice(&dev); hipDeviceGetAttribute(&cus, hipDeviceAttributeMultiprocessorCount, dev);
        if (hipFuncSetAttribute((const void*)mk_fwd, hipFuncAttributeMaxDynamicSharedMemorySize, LDS_BYTES) != hipSuccess) { fprintf(stderr, "kernel_launch: hipFuncSetAttribute failed\n"); grid = -1; return; }
        if (hipOccupancyMaxActiveBlocksPerMultiprocessor(&per_cu, (const void*)mk_fwd, NTHR, LDS_BYTES) != hipSuccess || per_cu < 1) { fprintf(stderr, "kernel_launch: occupancy query failed (%d)\n", per_cu); per_cu = 1; }
        (void)hipGetLastError();
        grid = cus * per_cu;
        if (grid != 256) { fprintf(stderr, "kernel_launch: built for a 256-workgroup grid (256 CUs x 1 workgroup), got %d; nothing launched\n", grid); grid = -1; return; }
        fprintf(stderr, "kernel_launch: cus %d per_cu %d grid %d\n", cus, per_cu, grid);
    }
    if (grid < 0) return;
    Args a{};
    for (int i = 0; i < 26; ++i) a.in[i] = (const float*)d_in[i];
    a.out = (float*)d_out; a.ws = (unsigned char*)d_ws;
#if MK_MODE == 0
    a.ph_lo = 0; a.ph_hi = NPH;
    if (hipMemsetAsync((char*)d_ws + WS_CTL, 0, 65536, stream) != hipSuccess) { fprintf(stderr, "kernel_launch: memset of the barrier words failed\n"); return; }
    void* kargs[] = {&a};
    hipError_t e = hipLaunchCooperativeKernel((const void*)mk_fwd, dim3(grid), dim3(NTHR), kargs, LDS_BYTES, stream);
    if (e != hipSuccess) fprintf(stderr, "kernel_launch: cooperative launch failed: %s (grid %d)\n", hipGetErrorString(e), grid);
#else
    for (int p = 0; p < NPH; ++p) { a.ph_lo = p; a.ph_hi = p + 1; hipLaunchKernelGGL(mk_fwd, dim3(grid), dim3(NTHR), LDS_BYTES, stream, a); }
#endif
}
```
